# Optimizing an MI355X kernel written in HIP

```python
import jax, jax.numpy as jnp
from jax import lax
import numpy as np

D_MODEL = 1024
BATCH = 8
SEQ = 4096
DEPTH = 4

PLE_DIM = 256
ROPE_THETA = 10000.0
NORM_EPS = 1e-6
BLOCK = 128
WINDOW = 128

A_HEADS = 8
A_KV_HEADS = 2
A_HEAD_DIM = 64
A_WIDTH = A_HEADS * A_HEAD_DIM

B_HEADS = 8
B_Q_LORA = 384
B_KV_LORA = 256
B_NOPE = 64
B_ROPE = 32
B_QK_DIM = B_NOPE + B_ROPE
B_V_DIM = 64
B_WIDTH = B_HEADS * B_V_DIM

MIX_WIDTH = A_WIDTH + B_WIDTH
IN_SIZES = (A_WIDTH, A_KV_HEADS * A_HEAD_DIM, A_KV_HEADS * A_HEAD_DIM, A_WIDTH,
            B_Q_LORA, B_KV_LORA, B_ROPE, B_WIDTH)
N_IN = 512 + 128 + 128 + 512 + 384 + 256 + 32 + 512

kernel_name = "hybrid_swa_sink_mla_parallel_heads"


def rmsnorm(x, g):
    xf = x.astype(jnp.float32)
    r = xf * lax.rsqrt(jnp.mean(xf * xf, axis=-1, keepdims=True) + NORM_EPS)
    return (r * g.astype(jnp.float32)).astype(x.dtype)


def rope(x, pos):
    d = x.shape[-1]
    half = d // 2
    inv = ROPE_THETA ** (-jnp.arange(half, dtype=jnp.float32) * 2.0 / d)
    ang = pos.astype(jnp.float32)[..., None] * inv
    cos = jnp.cos(ang)[:, :, None, :]
    sin = jnp.sin(ang)[:, :, None, :]
    xf = x.astype(jnp.float32)
    x1, x2 = xf[..., :half], xf[..., half:]
    return jnp.concatenate([x1 * cos - x2 * sin, x2 * cos + x1 * sin], axis=-1).astype(x.dtype)


def window_sink_attention(q, k, v, sink):
    B, S, H, d = q.shape
    KV = k.shape[2]
    G = H // KV
    nb = S // BLOCK
    scale = d ** -0.5
    pad = ((0, 0), (BLOCK, BLOCK), (0, 0), (0, 0))
    kp = jnp.pad(k, pad).reshape(B, nb + 2, BLOCK, KV, d)
    vp = jnp.pad(v, pad).reshape(B, nb + 2, BLOCK, KV, d)
    kb = jnp.concatenate([kp[:, :-2], kp[:, 1:-1], kp[:, 2:]], axis=2)
    vb = jnp.concatenate([vp[:, :-2], vp[:, 1:-1], vp[:, 2:]], axis=2)
    qb = q.reshape(B, nb, BLOCK, KV, G, d)
    s = jnp.einsum('bnqkgd,bnckd->bnkgqc', qb, kb).astype(jnp.float32) * scale
    qi = jnp.arange(BLOCK)[:, None]
    ci = jnp.arange(3 * BLOCK)[None, :]
    band = jnp.abs(ci - BLOCK - qi) <= WINDOW
    kpos = jnp.arange(nb)[:, None] * BLOCK - BLOCK + ci
    valid = (kpos >= 0) & (kpos < S)
    mask = band[None, :, :] & valid[:, None, :]
    s = jnp.where(mask[None, :, None, None, :, :], s, jnp.float32(-1e30))
    sink_l = jnp.broadcast_to(sink.astype(jnp.float32).reshape(1, 1, KV, G, 1, 1),
                              s.shape[:-1] + (1,))
    pr = jax.nn.softmax(jnp.concatenate([s, sink_l], axis=-1), axis=-1)[..., :-1]
    o = jnp.einsum('bnkgqc,bnckd->bnqkgd', pr.astype(v.dtype), vb)
    return o.reshape(B, S, H, d)


def dense_block_attention(q, k, v):
    B, S, H, d = q.shape
    nb = S // BLOCK
    scale = d ** -0.5
    qb = q.reshape(B, nb, BLOCK, H, d).transpose(1, 0, 2, 3, 4)

    def one_block(qblk):
        s = jnp.einsum('bqhd,bkhd->bhqk', qblk, k).astype(jnp.float32) * scale
        pr = jax.nn.softmax(s, axis=-1).astype(v.dtype)
        return jnp.einsum('bhqk,bkhd->bqhd', pr, v)

    o = lax.map(one_block, qb)
    return o.transpose(1, 0, 2, 3, 4).reshape(B, S, H, v.shape[-1])


def hybrid_layer(x, p_i, positions, norm_g, w_in, a_q_norm, a_k_norm, a_sink,
                 b_cq_norm, b_ckv_norm, b_w_uq, b_w_ukv, b_q_norm, b_k_norm,
                 w_out, ple_g, ple_w_gate, ple_w_proj):
    B, S, _ = x.shape
    h = rmsnorm(x, norm_g)
    z = h @ w_in
    idx = np.cumsum(np.array(IN_SIZES))[:-1].tolist()
    aq, ak, av, ag, bcq, bckv, bkr, bg = jnp.split(z, idx, axis=-1)

    qa = rope(rmsnorm(aq.reshape(B, S, A_HEADS, A_HEAD_DIM), a_q_norm), positions)
    ka = rope(rmsnorm(ak.reshape(B, S, A_KV_HEADS, A_HEAD_DIM), a_k_norm), positions)
    va = av.reshape(B, S, A_KV_HEADS, A_HEAD_DIM)
    oa = window_sink_attention(qa, ka, va, a_sink).reshape(B, S, A_WIDTH)
    oa = oa * jax.nn.silu(ag)

    qf = (rmsnorm(bcq, b_cq_norm) @ b_w_uq).reshape(B, S, B_HEADS, B_QK_DIM)
    kv = (rmsnorm(bckv, b_ckv_norm) @ b_w_ukv).reshape(B, S, B_HEADS, B_NOPE + B_V_DIM)
    k_nope, vb = kv[..., :B_NOPE], kv[..., B_NOPE:]
    k_rope = jnp.broadcast_to(bkr[:, :, None, :], (B, S, B_HEADS, B_ROPE))
    qf = rmsnorm(qf, b_q_norm)
    kf = rmsnorm(jnp.concatenate([k_nope, k_rope], axis=-1), b_k_norm)
    qb = jnp.concatenate([qf[..., :B_NOPE], rope(qf[..., B_NOPE:], positions)], axis=-1)
    kb = jnp.concatenate([kf[..., :B_NOPE], rope(kf[..., B_NOPE:], positions)], axis=-1)
    ob = dense_block_attention(qb, kb, vb).reshape(B, S, B_WIDTH)
    ob = ob * jax.nn.silu(bg)

    x = x + jnp.concatenate([oa, ob], axis=-1) @ w_out

    gate = jax.nn.sigmoid(rmsnorm(x, ple_g) @ ple_w_gate)
    return x + gate * (p_i @ ple_w_proj)


def setup_inputs(seed: int = 0) -> dict:
    key = jax.random.key(seed)
    ks = jax.random.split(key, 20)
    f32 = jnp.float32

    def nrm(k, shape, scale):
        return jax.random.normal(k, shape, f32) * scale

    def gain(k, shape):
        return 1.0 + 0.02 * jax.random.normal(k, shape, f32)

    out_scale = MIX_WIDTH ** -0.5 / np.sqrt(2.0 * DEPTH)
    return {
        "x": nrm(ks[0], (BATCH, SEQ, D_MODEL), 1.0),
        "p": nrm(ks[1], (DEPTH, BATCH, SEQ, PLE_DIM), 1.0),
        "positions": jnp.broadcast_to(jnp.arange(SEQ, dtype=jnp.int32)[None, :], (BATCH, SEQ)),
        "norm_g": gain(ks[2], (DEPTH, D_MODEL)),
        "w_in": nrm(ks[3], (DEPTH, D_MODEL, N_IN), D_MODEL ** -0.5),
        "a_q_norm": gain(ks[4], (DEPTH, A_HEAD_DIM)),
        "a_k_norm": gain(ks[5], (DEPTH, A_HEAD_DIM)),
        "a_sink": nrm(ks[6], (DEPTH, A_HEADS), 0.5),
        "b_cq_norm": gain(ks[7], (DEPTH, B_Q_LORA)),
        "b_ckv_norm": gain(ks[8], (DEPTH, B_KV_LORA)),
        "b_w_uq": nrm(ks[9], (DEPTH, B_Q_LORA, B_HEADS * B_QK_DIM), B_Q_LORA ** -0.5),
        "b_w_ukv": nrm(ks[10], (DEPTH, B_KV_LORA, B_HEADS * (B_NOPE + B_V_DIM)), B_KV_LORA ** -0.5),
        "b_q_norm": gain(ks[11], (DEPTH, B_QK_DIM)),
        "b_k_norm": gain(ks[12], (DEPTH, B_QK_DIM)),
        "w_out": nrm(ks[13], (DEPTH, MIX_WIDTH, D_MODEL), out_scale),
        "ple_g": gain(ks[14], (DEPTH, D_MODEL)),
        "ple_w_gate": nrm(ks[15], (DEPTH, D_MODEL, D_MODEL), D_MODEL ** -0.5),
        "ple_w_proj": nrm(ks[16], (DEPTH, PLE_DIM, D_MODEL), 0.5 * PLE_DIM ** -0.5),
    }


def reference(x, p, positions, norm_g, w_in, a_q_norm, a_k_norm, a_sink,
              b_cq_norm, b_ckv_norm, b_w_uq, b_w_ukv, b_q_norm, b_k_norm,
              w_out, ple_g, ple_w_gate, ple_w_proj):
    for i in range(DEPTH):
        x = hybrid_layer(x, p[i], positions, norm_g[i], w_in[i], a_q_norm[i], a_k_norm[i],
                         a_sink[i], b_cq_norm[i], b_ckv_norm[i], b_w_uq[i], b_w_ukv[i],
                         b_q_norm[i], b_k_norm[i], w_out[i], ple_g[i], ple_w_gate[i],
                         ple_w_proj[i])
    return x
```

```cpp
#include <hip/hip_runtime.h>
#include <hip/hip_cooperative_groups.h>
#include <stdint.h>
#include <math.h>
#include <stdio.h>
#include <string.h>
namespace cg = cooperative_groups;

#define T_TOK 32768
#define SEQ 4096
#define LAS __attribute__((address_space(3)))
#define LOG2E 1.4426950408889634f
#define QA_SCALE (0.125f * LOG2E)
#define QB_SCALE (0.10206207261596575f * LOG2E)

typedef short bf16x8 __attribute__((ext_vector_type(8)));
typedef short s16x4 __attribute__((ext_vector_type(4)));
typedef float f32x16 __attribute__((ext_vector_type(16)));
typedef float f32x4 __attribute__((ext_vector_type(4)));
typedef float f32x2 __attribute__((ext_vector_type(2)));
typedef unsigned u32x4 __attribute__((ext_vector_type(4)));
typedef unsigned u32x2 __attribute__((ext_vector_type(2)));
typedef __bf16 bf2_t __attribute__((ext_vector_type(2)));
typedef unsigned short bf16_t;

#define MFMA32(a, b, c) __builtin_amdgcn_mfma_f32_32x32x16_bf16((a), (b), (c), 0, 0, 0)

struct Params {
  const float* x; const float* p; const int* pos;
  const float* norm_g; const float* w_in; const float* a_q_norm; const float* a_k_norm; const float* a_sink;
  const float* b_cq_norm; const float* b_ckv_norm; const float* b_w_uq; const float* b_w_ukv; const float* b_q_norm; const float* b_k_norm;
  const float* w_out; const float* ple_g; const float* ple_w_gate; const float* ple_w_proj;
  float* out;
  bf16_t* WinT; bf16_t* WuqT; bf16_t* WukvT; bf16_t* WoutT; bf16_t* WgT; bf16_t* WpT;
  float* cosA; float* sinA; float* cosB; float* sinB;
  bf16_t* xbA; bf16_t* xbB; bf16_t* Qa; bf16_t* Ka; bf16_t* Va; bf16_t* G; bf16_t* cq; bf16_t* ckv;
  bf16_t* Qb; bf16_t* Kb; bf16_t* Vb; bf16_t* mix; bf16_t* pe; bf16_t* pb;
  float* bkr; float* ssqX; float* ssq1; float* ssqcq; float* ssqckv;
  unsigned* bar; int* flags;
  float invA[32]; float invB[16];
};

__device__ __forceinline__ int crow(int e, int h) { return (e & 3) + 8 * (e >> 2) + 4 * h; }
__device__ __forceinline__ unsigned pk2(float a, float b) { f32x2 v = {a, b}; bf2_t r = __builtin_convertvector(v, bf2_t); return __builtin_bit_cast(unsigned, r); }
__device__ __forceinline__ u32x4 pk8(float a0, float a1, float a2, float a3, float a4, float a5, float a6, float a7) {
  u32x4 r; r.x = pk2(a0, a1); r.y = pk2(a2, a3); r.z = pk2(a4, a5); r.w = pk2(a6, a7); return r;
}
__device__ __forceinline__ float bflo(unsigned u) { return __uint_as_float(u << 16); }
__device__ __forceinline__ float bfhi(unsigned u) { return __uint_as_float(u & 0xffff0000u); }
__device__ __forceinline__ float sigmoidf_(float x) { return __builtin_amdgcn_rcpf(1.0f + __expf(-x)); }

template <int CTRL> __device__ __forceinline__ float dppf(float v) { return __int_as_float(__builtin_amdgcn_update_dpp(0, __float_as_int(v), CTRL, 0xF, 0xF, true)); }
__device__ __forceinline__ float sum8(float v) { v += dppf<0xB1>(v); v += dppf<0x4E>(v); v += dppf<0x141>(v); return v; }
__device__ __forceinline__ float sum16(float v) { v = sum8(v); v += dppf<0x140>(v); return v; }
__device__ __forceinline__ float lane_xor2(float v) { return dppf<0x4E>(v); }
__device__ __forceinline__ float lane_xor4(float v) { return dppf<0x1B>(dppf<0x141>(v)); }
__device__ __forceinline__ float shflx(float v, int mask, int lane) { return __int_as_float(__builtin_amdgcn_ds_bpermute((lane ^ mask) << 2, __float_as_int(v))); }
__device__ __forceinline__ int tid_opaque() { int z; asm volatile("s_mov_b32 %0, 0" : "=s"(z)); return (int)threadIdx.x + z; }

__device__ __forceinline__ bool next_tile(int it, int ntiles, int& tile) {
  const int G8 = gridDim.x >> 3, b = blockIdx.x;
  const int per = ntiles >> 3;
  const int idx = it * G8 + (b >> 3);
  if (idx >= per) return false;
  tile = (b & 7) * per + idx;
  return true;
}

__device__ __forceinline__ bool next_tile2(int it, int nt2, int& m, int& n) {
  const int G8 = gridDim.x >> 3, b = blockIdx.x;
  const int idx = it * G8 + (b >> 3);
  if (idx >= 32 * nt2) return false;
  const int g = idx >> 6, j = idx & 63;
  m = 32 * (b & 7) + (j >> 1); n = 2 * g + (j & 1);
  return true;
}

__device__ __forceinline__ void norm96_rope_store(float (&v)[8], const int lane, const int chunk, const float* __restrict__ gain, const float* __restrict__ cosB, const float* __restrict__ sinB,
                                                  const int tok, const float scale, bf16_t* __restrict__ dst) {
  float ss = 0.f;
#pragma unroll
  for (int j = 0; j < 8; ++j) ss += v[j] * v[j];
  ss = sum16(ss);
  const float rinv = rsqrtf(ss * (1.f / 96.f) + 1e-6f);
  const int cc = chunk < 12 ? chunk : 0;
  float vn[8], o[8];
#pragma unroll
  for (int j = 0; j < 8; ++j) vn[j] = v[j] * rinv * gain[cc * 8 + j];
  const bool isrope = (chunk >= 8) && (chunk < 12);
  const bool first = chunk < 10;
  const int fi = (chunk & 1) * 8;
#pragma unroll
  for (int j = 0; j < 8; ++j) {
    const float pr = lane_xor2(vn[j]);
    const float c = cosB[tok * 16 + fi + j], s = sinB[tok * 16 + fi + j];
    const float rv = first ? (vn[j] * c - pr * s) : (vn[j] * c + pr * s);
    o[j] = (isrope ? rv : vn[j]) * scale;
  }
  if (chunk < 12) *(u32x4*)(dst + chunk * 8) = pk8(o[0], o[1], o[2], o[3], o[4], o[5], o[6], o[7]);
}

typedef float f32x4acc __attribute__((ext_vector_type(4)));
#define MFMA16(a, b, c) __builtin_amdgcn_mfma_f32_16x16x32_bf16((a), (b), (c), 0, 0, 0)
template <bool EARLYBAR>
__device__ __forceinline__ void gemm2_main(const bf16_t* __restrict__ Ag, const bf16_t* __restrict__ Bg, const int K, const int m0, const int n0,
                                           LAS char* lds, f32x4acc (&acc)[4][8]) {
  const int t = tid_opaque(), lane = t & 63, w = t >> 6, fr = lane & 15, fq = lane >> 4, wr = w >> 1, wc = w & 1;
  const int lrow = t >> 3, lc8 = t & 7;
  const char* Ab = (const char*)(Ag + (size_t)m0 * K);
  const char* Bb = (const char*)(Bg + (size_t)n0 * K);
  const unsigned toff = (unsigned)(lrow * K + lc8 * 8) * 2u;
  const unsigned rsb = (unsigned)K * 64u;
  u32x4 ra[4], rb[8];
#pragma unroll
  for (int i = 0; i < 4; ++i)
#pragma unroll
    for (int j = 0; j < 8; ++j) acc[i][j] = (f32x4acc){0.f, 0.f, 0.f, 0.f};
  const int nk = K >> 6;
  const int soff = lrow * 160 + lc8 * 16;
#pragma unroll
  for (int i = 0; i < 4; ++i) ra[i] = *(const u32x4*)(Ab + (toff + i * rsb));
#pragma unroll
  for (int i = 0; i < 8; ++i) rb[i] = *(const u32x4*)(Bb + (toff + i * rsb));
  const int aoff = (wr * 64 + fr) * 160 + fq * 16;
  const int boff = 20480 + (wc * 64 + fr) * 160 + fq * 16;
  for (int kt = 0; kt < nk; ++kt) {
#pragma unroll
    for (int i = 0; i < 4; ++i) *(LAS u32x4*)(lds + i * 5120 + soff) = ra[i];
#pragma unroll
    for (int i = 0; i < 8; ++i) *(LAS u32x4*)(lds + 20480 + i * 5120 + soff) = rb[i];
    __syncthreads();
    if (kt + 1 < nk) {
      const unsigned k0 = (unsigned)(kt + 1) << 7;
#pragma unroll
      for (int i = 0; i < 4; ++i) ra[i] = *(const u32x4*)(Ab + (toff + i * rsb + k0));
#pragma unroll
      for (int i = 0; i < 8; ++i) rb[i] = *(const u32x4*)(Bb + (toff + i * rsb + k0));
    }
#pragma unroll
    for (int ks = 0; ks < 2; ++ks) {
      bf16x8 af[4];
#pragma unroll
      for (int i = 0; i < 4; ++i) af[i] = *(LAS const bf16x8*)(lds + aoff + i * 2560 + ks * 64);
#pragma unroll
      for (int hh = 0; hh < 2; ++hh) {
        bf16x8 bfr[4];
#pragma unroll
        for (int j = 0; j < 4; ++j) bfr[j] = *(LAS const bf16x8*)(lds + boff + (hh * 128 + j * 16) * 160 + ks * 64);
        if (EARLYBAR && ks == 1 && hh == 1) __syncthreads();
#pragma unroll
        for (int i = 0; i < 4; ++i)
#pragma unroll
          for (int j = 0; j < 4; ++j) acc[i][hh * 4 + j] = MFMA16(bfr[j], af[i], acc[i][hh * 4 + j]);
      }
    }
    if (!EARLYBAR) __syncthreads();
  }
}

template <bool EARLYBAR>
__device__ __forceinline__ void gemm2_main_smallk(const bf16_t* __restrict__ Ag, const bf16_t* __restrict__ Bg, const int K, const int m0, const int n0,
                                           LAS char* lds, f32x4acc (&acc)[4][8]) {
  const int t = tid_opaque(), lane = t & 63, w = t >> 6, fr = lane & 15, fq = lane >> 4, wr = w >> 1, wc = w & 1;
  const int lrow = t >> 3, lc8 = t & 7;
  const char* Ab = (const char*)(Ag + (size_t)m0 * K);
  const char* Bb = (const char*)(Bg + (size_t)n0 * K);
  const unsigned toff = (unsigned)(lrow * K + lc8 * 8) * 2u;
  const unsigned rsb = (unsigned)K * 64u;
  u32x4 ra[4], rb[8];
#pragma unroll
  for (int i = 0; i < 4; ++i)
#pragma unroll
    for (int j = 0; j < 8; ++j) acc[i][j] = (f32x4acc){0.f, 0.f, 0.f, 0.f};
  const int nk = K >> 6;
  const int soff = lrow * 160 + lc8 * 16;
#pragma unroll
  for (int i = 0; i < 4; ++i) ra[i] = *(const u32x4*)(Ab + (toff + i * rsb));
#pragma unroll
  for (int i = 0; i < 8; ++i) rb[i] = *(const u32x4*)(Bb + (toff + i * rsb));
  const int aoff = (wr * 64 + fr) * 160 + fq * 16;
  const int boff = 20480 + (wc * 64 + fr) * 160 + fq * 16;
#pragma unroll 1
  for (int kt = 0; kt < nk; ++kt) {
#pragma unroll
    for (int i = 0; i < 4; ++i) *(LAS u32x4*)(lds + i * 5120 + soff) = ra[i];
#pragma unroll
    for (int i = 0; i < 8; ++i) *(LAS u32x4*)(lds + 20480 + i * 5120 + soff) = rb[i];
    __syncthreads();
    if (kt + 1 < nk) {
      const unsigned k0 = (unsigned)(kt + 1) << 7;
#pragma unroll
      for (int i = 0; i < 4; ++i) ra[i] = *(const u32x4*)(Ab + (toff + i * rsb + k0));
#pragma unroll
      for (int i = 0; i < 8; ++i) rb[i] = *(const u32x4*)(Bb + (toff + i * rsb + k0));
    }
#pragma unroll
    for (int ks = 0; ks < 2; ++ks) {
      bf16x8 af[4];
#pragma unroll
      for (int i = 0; i < 4; ++i) af[i] = *(LAS const bf16x8*)(lds + aoff + i * 2560 + ks * 64);
#pragma unroll
      for (int hh = 0; hh < 2; ++hh) {
        bf16x8 bfr[4];
#pragma unroll
        for (int j = 0; j < 4; ++j) bfr[j] = *(LAS const bf16x8*)(lds + boff + (hh * 128 + j * 16) * 160 + ks * 64);
        if (EARLYBAR && ks == 1 && hh == 1) __syncthreads();
#pragma unroll
        for (int i = 0; i < 4; ++i)
#pragma unroll
          for (int j = 0; j < 4; ++j) acc[i][hh * 4 + j] = MFMA16(bfr[j], af[i], acc[i][hh * 4 + j]);
      }
    }
    if (!EARLYBAR) __syncthreads();
  }
}

__device__ __forceinline__ void dump_half(LAS float* C, const f32x4acc (&acc)[4][8], const int hf) {
  const int t = tid_opaque(), lane = t & 63, w = t >> 6, fr = lane & 15, fq = lane >> 4, wr = w >> 1, wc = w & 1;
#pragma unroll
  for (int i = 0; i < 4; ++i)
#pragma unroll
    for (int nj = 0; nj < 4; ++nj)
      *(LAS f32x4acc*)(C + (wr * 64 + i * 16 + fr) * 132 + wc * 64 + nj * 16 + fq * 4) = hf ? acc[i][4 + nj] : acc[i][nj];
}

struct EpiPre { f32x4 x0[8], x1[8]; u32x4 pv[8]; };
template <int SEG>
__device__ __forceinline__ void epi_prefetch(const Params& P, const int layer, const int mt, const int nt, EpiPre& pre) {
  const int t = tid_opaque(), chunk = t & 15, rsub = t >> 4;
#pragma unroll
  for (int pass = 0; pass < 8; ++pass) {
    const int tok = mt * 128 + pass * 16 + rsub;
    const float* xin = ((SEG == 8 && layer == 0) ? P.x : (const float*)P.out) + (size_t)tok * 1024 + nt * 128 + chunk * 8;
    pre.x0[pass] = *(const f32x4*)xin; pre.x1[pass] = *(const f32x4*)(xin + 4);
    if (SEG == 10) pre.pv[pass] = *(const u32x4*)(P.pe + (size_t)tok * 1024 + nt * 128 + chunk * 8);
  }
}

template <int SEG>
__device__ __forceinline__ void epi_loop(const Params& P, const int layer, const int mt, const int nt, LAS const float* C, LAS const float* rsl, const EpiPre& pre) {
  const int t = tid_opaque(), chunk = t & 15, rsub = t >> 4;
#pragma unroll
  for (int pass = 0; pass < 8; ++pass) {
    const int row = pass * 16 + rsub;
    const int tok = mt * 128 + row;
    const int b = tok >> 12, s = tok & 4095;
    const f32x4 c0 = *(LAS const f32x4*)(C + row * 132 + chunk * 8);
    const f32x4 c1 = *(LAS const f32x4*)(C + row * 132 + chunk * 8 + 4);
    float v[8] = {c0.x, c0.y, c0.z, c0.w, c1.x, c1.y, c1.z, c1.w};
    if (SEG <= 7 || SEG == 10) {
      const float rs = rsl[row];
      if (SEG != 10) {
#pragma unroll
        for (int j = 0; j < 8; ++j) v[j] *= rs;
      }
    }
    if (SEG == 1) {
      float ss = 0.f;
#pragma unroll
      for (int j = 0; j < 8; ++j) ss += v[j] * v[j];
      ss = sum8(ss);
      const float rinv = rsqrtf(ss * (1.f / 64.f) + 1e-6f);
      const int d0 = (chunk & 7) * 8;
      const float* gn = (nt < 4 ? P.a_q_norm : P.a_k_norm) + layer * 64 + d0;
      const float* cs = P.cosA + tok * 32 + (d0 & 31);
      const float* sn = P.sinA + tok * 32 + (d0 & 31);
      const f32x4 cs0 = *(const f32x4*)cs, cs1 = *(const f32x4*)(cs + 4), sn0 = *(const f32x4*)sn, sn1 = *(const f32x4*)(sn + 4);
      const float cc[8] = {cs0.x, cs0.y, cs0.z, cs0.w, cs1.x, cs1.y, cs1.z, cs1.w};
      const float sv[8] = {sn0.x, sn0.y, sn0.z, sn0.w, sn1.x, sn1.y, sn1.z, sn1.w};
      const bool first = d0 < 32;
      const float scale = nt < 4 ? QA_SCALE : 1.0f;
      float o[8];
#pragma unroll
      for (int j = 0; j < 8; ++j) {
        const float vn = v[j] * rinv * gn[j];
        const float pr = lane_xor4(vn);
        o[j] = (first ? (vn * cc[j] - pr * sv[j]) : (vn * cc[j] + pr * sv[j])) * scale;
      }
      bf16_t* dst;
      if (nt < 4) { const int head = nt * 2 + (chunk >> 3); dst = P.Qa + ((size_t)((b * 8 + head) * SEQ + s)) * 64 + d0; }
      else { const int kvh = chunk >> 3; dst = P.Ka + ((size_t)((b * 2 + kvh) * SEQ + s)) * 64 + d0; }
      *(u32x4*)dst = pk8(o[0], o[1], o[2], o[3], o[4], o[5], o[6], o[7]);
    } else if (SEG == 2) {
      const int kvh = chunk >> 3, d0 = (chunk & 7) * 8;
      *(u32x4*)(P.Va + ((size_t)((b * 2 + kvh) * SEQ + s)) * 64 + d0) = pk8(v[0], v[1], v[2], v[3], v[4], v[5], v[6], v[7]);
    } else if (SEG == 3) {
      const int colb = nt < 10 ? (nt - 6) * 128 : 512 + (nt - 15) * 128;
      float o[8];
#pragma unroll
      for (int j = 0; j < 8; ++j) o[j] = v[j] * sigmoidf_(v[j]);
      *(u32x4*)(P.G + (size_t)tok * 1024 + colb + chunk * 8) = pk8(o[0], o[1], o[2], o[3], o[4], o[5], o[6], o[7]);
    } else if (SEG == 4) {
      float ss = 0.f;
#pragma unroll
      for (int j = 0; j < 8; ++j) ss += v[j] * v[j];
      ss = sum16(ss);
      if (nt < 13) {
        *(u32x4*)(P.cq + (size_t)tok * 384 + (nt - 10) * 128 + chunk * 8) = pk8(v[0], v[1], v[2], v[3], v[4], v[5], v[6], v[7]);
        if (chunk == 0) P.ssqcq[tok * 4 + (nt - 10)] = ss;
      } else {
        *(u32x4*)(P.ckv + (size_t)tok * 256 + (nt - 13) * 128 + chunk * 8) = pk8(v[0], v[1], v[2], v[3], v[4], v[5], v[6], v[7]);
        if (chunk == 0) P.ssqckv[tok * 2 + (nt - 13)] = ss;
      }
    } else if (SEG == 5) {
      if (chunk < 4) {
        *(f32x4*)(P.bkr + (size_t)tok * 32 + chunk * 8) = (f32x4){v[0], v[1], v[2], v[3]};
        *(f32x4*)(P.bkr + (size_t)tok * 32 + chunk * 8 + 4) = (f32x4){v[4], v[5], v[6], v[7]};
      }
    } else if (SEG == 6) {
#pragma unroll
      for (int j = 0; j < 8; ++j) v[j] = (chunk < 12) ? v[j] : 0.f;
      norm96_rope_store(v, t & 63, chunk, P.b_q_norm + layer * 96, P.cosB, P.sinB, tok, QB_SCALE, P.Qb + ((size_t)((b * 8 + nt) * SEQ + s)) * 96);
    } else if (SEG == 7) {
      if (chunk >= 8) *(u32x4*)(P.Vb + ((size_t)((b * 8 + nt) * SEQ + s)) * 64 + (chunk - 8) * 8) = pk8(v[0], v[1], v[2], v[3], v[4], v[5], v[6], v[7]);
      if (chunk >= 8) {
        if (chunk < 12) {
          const f32x4 k0 = *(const f32x4*)(P.bkr + (size_t)tok * 32 + (chunk - 8) * 8);
          const f32x4 k1 = *(const f32x4*)(P.bkr + (size_t)tok * 32 + (chunk - 8) * 8 + 4);
          v[0] = k0.x; v[1] = k0.y; v[2] = k0.z; v[3] = k0.w; v[4] = k1.x; v[5] = k1.y; v[6] = k1.z; v[7] = k1.w;
        } else {
#pragma unroll
          for (int j = 0; j < 8; ++j) v[j] = 0.f;
        }
      }
      norm96_rope_store(v, t & 63, chunk, P.b_k_norm + layer * 96, P.cosB, P.sinB, tok, 1.0f, P.Kb + ((size_t)((b * 8 + nt) * SEQ + s)) * 96);
    } else if (SEG == 8) {
      const f32x4 x0 = pre.x0[pass], x1 = pre.x1[pass];
      v[0] += x0.x; v[1] += x0.y; v[2] += x0.z; v[3] += x0.w; v[4] += x1.x; v[5] += x1.y; v[6] += x1.z; v[7] += x1.w;
      float ss = 0.f;
#pragma unroll
      for (int j = 0; j < 8; ++j) ss += v[j] * v[j];
      ss = sum16(ss);
      float* o = P.out + (size_t)tok * 1024 + nt * 128 + chunk * 8;
      *(f32x4*)o = (f32x4){v[0], v[1], v[2], v[3]};
      *(f32x4*)(o + 4) = (f32x4){v[4], v[5], v[6], v[7]};
      *(u32x4*)(P.xbB + (size_t)tok * 1024 + nt * 128 + chunk * 8) = pk8(v[0], v[1], v[2], v[3], v[4], v[5], v[6], v[7]);
      if (chunk == 0) P.ssq1[tok * 8 + nt] = ss;
    } else if (SEG == 9) {
      *(u32x4*)(P.pe + (size_t)tok * 1024 + nt * 128 + chunk * 8) = pk8(v[0], v[1], v[2], v[3], v[4], v[5], v[6], v[7]);
    } else {
      const float rs = rsl[row];
      float* o = P.out + (size_t)tok * 1024 + nt * 128 + chunk * 8;
      const f32x4 x0 = pre.x0[pass], x1 = pre.x1[pass];
      const u32x4 pv = pre.pv[pass];
      float xo[8] = {x0.x, x0.y, x0.z, x0.w, x1.x, x1.y, x1.z, x1.w};
      const float pe[8] = {bflo(pv.x), bfhi(pv.x), bflo(pv.y), bfhi(pv.y), bflo(pv.z), bfhi(pv.z), bflo(pv.w), bfhi(pv.w)};
      float ss = 0.f;
#pragma unroll
      for (int j = 0; j < 8; ++j) { xo[j] += sigmoidf_(v[j] * rs) * pe[j]; ss += xo[j] * xo[j]; }
      ss = sum16(ss);
      *(f32x4*)o = (f32x4){xo[0], xo[1], xo[2], xo[3]};
      *(f32x4*)(o + 4) = (f32x4){xo[4], xo[5], xo[6], xo[7]};
      *(u32x4*)(P.xbA + (size_t)tok * 1024 + nt * 128 + chunk * 8) = pk8(xo[0], xo[1], xo[2], xo[3], xo[4], xo[5], xo[6], xo[7]);
      if (chunk == 0) P.ssqX[tok * 8 + nt] = ss;
    }
  }
}

template <int MODE>
__device__ __forceinline__ void epilogue(const Params& P, const int layer, const int mt, const int nt, LAS const float* C, LAS const float* rsl, const EpiPre& pre) {
  if (MODE == 1) {
    if (nt < 5) epi_loop<1>(P, layer, mt, nt, C, rsl, pre);
    else if (nt == 5) epi_loop<2>(P, layer, mt, nt, C, rsl, pre);
    else if (nt < 10 || (nt >= 15 && nt < 19)) epi_loop<3>(P, layer, mt, nt, C, rsl, pre);
    else if (nt < 15) epi_loop<4>(P, layer, mt, nt, C, rsl, pre);
    else epi_loop<5>(P, layer, mt, nt, C, rsl, pre);
  } else if (MODE == 2) epi_loop<6>(P, layer, mt, nt, C, rsl, pre);
  else if (MODE == 3) epi_loop<7>(P, layer, mt, nt, C, rsl, pre);
  else if (MODE == 4) epi_loop<8>(P, layer, mt, nt, C, rsl, pre);
  else if (MODE == 5) epi_loop<9>(P, layer, mt, nt, C, rsl, pre);
  else epi_loop<10>(P, layer, mt, nt, C, rsl, pre);
}

template <int MODE>
__device__ __forceinline__ void gemm2_tile(const Params& P, const int layer, const bf16_t* A, const bf16_t* Bt, const int K, const int mt, const int nt2, LAS char* lds) {
  float rs_mine = 0.f;
  const int t = tid_opaque();
  if (MODE != 4 && MODE != 5 && t < 128) {
    const int tok = mt * 128 + t;
    if (MODE == 1 || MODE == 6) {
      const float* sp = (MODE == 1 ? P.ssqX : P.ssq1) + tok * 8;
      const f32x4 a = *(const f32x4*)sp, bb = *(const f32x4*)(sp + 4);
      rs_mine = rsqrtf((((a.x + a.y) + (a.z + a.w)) + ((bb.x + bb.y) + (bb.z + bb.w))) * (1.f / 1024.f) + 1e-6f);
    } else if (MODE == 2) {
      const f32x4 a = *(const f32x4*)(P.ssqcq + tok * 4);
      rs_mine = rsqrtf((a.x + a.y + a.z) * (1.f / 384.f) + 1e-6f);
    } else {
      const f32x2 a = *(const f32x2*)(P.ssqckv + tok * 2);
      rs_mine = rsqrtf((a.x + a.y) * (1.f / 256.f) + 1e-6f);
    }
  }
  LAS float* rsl = (LAS float*)(lds + 67584);
  if (MODE != 4 && MODE != 5 && t < 128) rsl[t] = rs_mine;
  f32x4acc acc[4][8];
  if (MODE == 1 || MODE == 4 || MODE == 6) gemm2_main<true>(A, Bt, K, mt * 128, nt2 * 256, lds, acc);
  else gemm2_main_smallk<true>(A, Bt, K, mt * 128, nt2 * 256, lds, acc);
#pragma unroll
  for (int hf = 0; hf < 2; ++hf) {
    EpiPre pre;
    if (MODE == 4) epi_prefetch<8>(P, layer, mt, nt2 * 2 + hf, pre);
    if (MODE == 6) epi_prefetch<10>(P, layer, mt, nt2 * 2 + hf, pre);
    dump_half((LAS float*)lds, acc, hf);
    __syncthreads();
    epilogue<MODE>(P, layer, mt, nt2 * 2 + hf, (LAS const float*)lds, rsl, pre);
    __syncthreads();
  }
}


template <int DQK, bool WIN>
__device__ __forceinline__ void attn_item(const Params& P, const int layer, const int b, const int head, const int qblk, LAS char* lds) {
  constexpr int KS = DQK / 16;
  constexpr int PK = DQK * 2 + 16;
  constexpr int PV = 192;
  constexpr int KTILE = 64 * PK, VTILE = 64 * PV;
  constexpr int KCH = DQK / 8;
  constexpr int NKL = 64 * KCH / 256;
  const int t = tid_opaque(), w = t >> 6, lane = t & 63, r = lane & 31, h = lane >> 5;
  const int q0 = qblk * 128;
  const bf16_t *Qp, *Kp, *Vp;
  if (WIN) {
    const int kvh = head >> 2;
    Qp = P.Qa + (size_t)(b * 8 + head) * SEQ * 64; Kp = P.Ka + (size_t)(b * 2 + kvh) * SEQ * 64; Vp = P.Va + (size_t)(b * 2 + kvh) * SEQ * 64;
  } else {
    Qp = P.Qb + (size_t)(b * 8 + head) * SEQ * 96; Kp = P.Kb + (size_t)(b * 8 + head) * SEQ * 96; Vp = P.Vb + (size_t)(b * 8 + head) * SEQ * 64;
  }
  const int klo = WIN ? (q0 >= 128 ? q0 - 128 : 0) : 0;
  const int khi = WIN ? (q0 + 256 <= SEQ ? q0 + 256 : SEQ) : SEQ;
  const int ntl = (khi - klo) >> 6;
  bf16x8 qf[KS];
  {
    const bf16_t* qrow = Qp + (size_t)(q0 + w * 32 + r) * DQK + h * 8;
#pragma unroll
    for (int ks = 0; ks < KS; ++ks) qf[ks] = *(const bf16x8*)(qrow + ks * 16);
  }
  f32x16 O[2];
#pragma unroll
  for (int e = 0; e < 16; ++e) { O[0][e] = 0.f; O[1][e] = 0.f; }
  float m, l;
  if (WIN) { m = P.a_sink[layer * 8 + head] * LOG2E; l = (h == 0) ? 1.f : 0.f; } else { m = -1e30f; l = 0.f; }
  const int qpos = q0 + w * 32 + r;

  u32x4 rk[NKL], rv[2];
  const char* Kg = (const char*)(Kp + (size_t)klo * DQK);
  const char* Vg = (const char*)(Vp + (size_t)klo * 64);
  int koff[NKL], voff[2];
#pragma unroll
  for (int i = 0; i < NKL; ++i) { const int c = t + 256 * i; koff[i] = (c / KCH) * PK + (c % KCH) * 16; }
#pragma unroll
  for (int i = 0; i < 2; ++i) { const int c = t + 256 * i; voff[i] = (c >> 3) * PV + (c & 7) * 16; }
  const int i16 = lane & 15, tq = i16 >> 2, tp = i16 & 3, blk = (lane >> 4) & 1;
  const int troff = (4 * h + tq) * PV + blk * 32 + tp * 8;

#pragma unroll
  for (int i = 0; i < NKL; ++i) rk[i] = *(const u32x4*)(Kg + (size_t)(t + 256 * i) * 16);
#pragma unroll
  for (int i = 0; i < 2; ++i) rv[i] = *(const u32x4*)(Vg + (size_t)(t + 256 * i) * 16);
#pragma unroll
  for (int i = 0; i < NKL; ++i) *(LAS u32x4*)(lds + koff[i]) = rk[i];
#pragma unroll
  for (int i = 0; i < 2; ++i) *(LAS u32x4*)(lds + KTILE + voff[i]) = rv[i];
  __syncthreads();

  for (int kt = 0; kt < ntl; ++kt) {
    const bool more = (kt + 1 < ntl);
    if (more) {
      const char* kg = Kg + (size_t)(kt + 1) * 64 * DQK * 2;
      const char* vg = Vg + (size_t)(kt + 1) * 64 * 64 * 2;
#pragma unroll
      for (int i = 0; i < NKL; ++i) rk[i] = *(const u32x4*)(kg + (size_t)(t + 256 * i) * 16);
#pragma unroll
      for (int i = 0; i < 2; ++i) rv[i] = *(const u32x4*)(vg + (size_t)(t + 256 * i) * 16);
    }
    LAS const char* sK = lds + (kt & 1) * (KTILE + VTILE);
    LAS const char* sV = sK + KTILE;
    f32x16 S[2];
#pragma unroll
    for (int sub = 0; sub < 2; ++sub) {
#pragma unroll
      for (int e = 0; e < 16; ++e) S[sub][e] = 0.f;
#pragma unroll
      for (int ks = 0; ks < KS; ++ks) {
        const bf16x8 kf = *(LAS const bf16x8*)(sK + (sub * 32 + r) * PK + ks * 32 + h * 16);
        S[sub] = MFMA32(kf, qf[ks], S[sub]);
      }
    }
    if (WIN) {
      const int kb = klo + kt * 64;
#pragma unroll
      for (int sub = 0; sub < 2; ++sub)
#pragma unroll
        for (int e = 0; e < 16; ++e) {
          const int d = kb + sub * 32 + crow(e, h) - qpos;
          if (d > 128 || d < -128) S[sub][e] = -1e30f;
        }
    }
    float mx = S[0][0];
#pragma unroll
    for (int e = 1; e < 16; ++e) mx = fmaxf(mx, S[0][e]);
#pragma unroll
    for (int e = 0; e < 16; ++e) mx = fmaxf(mx, S[1][e]);
    mx = fmaxf(mx, shflx(mx, 32, lane));
    const float mn = fmaxf(m, mx);
    const float alpha = __builtin_amdgcn_exp2f(m - mn);
    m = mn;
    float ls = 0.f;
#pragma unroll
    for (int sub = 0; sub < 2; ++sub)
#pragma unroll
      for (int e = 0; e < 16; ++e) { const float pv = __builtin_amdgcn_exp2f(S[sub][e] - mn); S[sub][e] = pv; ls += pv; }
    l = l * alpha + ls;
#pragma unroll
    for (int e = 0; e < 16; ++e) { O[0][e] *= alpha; O[1][e] *= alpha; }
#pragma unroll
    for (int sub = 0; sub < 2; ++sub)
#pragma unroll
      for (int s2 = 0; s2 < 2; ++s2) {
        u32x4 pw;
        pw.x = pk2(S[sub][8 * s2 + 0], S[sub][8 * s2 + 1]); pw.y = pk2(S[sub][8 * s2 + 2], S[sub][8 * s2 + 3]);
        pw.z = pk2(S[sub][8 * s2 + 4], S[sub][8 * s2 + 5]); pw.w = pk2(S[sub][8 * s2 + 6], S[sub][8 * s2 + 7]);
        const bf16x8 pf = __builtin_bit_cast(bf16x8, pw);
#pragma unroll
        for (int dvt = 0; dvt < 2; ++dvt) {
          LAS const char* va = sV + (sub * 32 + s2 * 16) * PV + dvt * 64 + troff;
          const s16x4 lo = __builtin_amdgcn_ds_read_tr16_b64_v4i16((LAS s16x4*)(va));
          const s16x4 hi = __builtin_amdgcn_ds_read_tr16_b64_v4i16((LAS s16x4*)(va + 8 * PV));
          const bf16x8 vf = __builtin_shufflevector(lo, hi, 0, 1, 2, 3, 4, 5, 6, 7);
          O[dvt] = MFMA32(vf, pf, O[dvt]);
        }
      }
    if (more) {
      LAS char* dK = lds + ((kt + 1) & 1) * (KTILE + VTILE);
#pragma unroll
      for (int i = 0; i < NKL; ++i) *(LAS u32x4*)(dK + koff[i]) = rk[i];
#pragma unroll
      for (int i = 0; i < 2; ++i) *(LAS u32x4*)(dK + KTILE + voff[i]) = rv[i];
    }
    __syncthreads();
  }
  l += shflx(l, 32, lane);
  const float inv = 1.0f / l;
  const int tok = b * SEQ + qpos;
  const int colb = (WIN ? 0 : 512) + head * 64;
  const bf16_t* gp = P.G + (size_t)tok * 1024 + colb;
  bf16_t* op = P.mix + (size_t)tok * 1024 + colb;
#pragma unroll
  for (int dvt = 0; dvt < 2; ++dvt)
#pragma unroll
    for (int g = 0; g < 4; ++g) {
      const int dv = dvt * 32 + 8 * g + 4 * h;
      const u32x2 gv = *(const u32x2*)(gp + dv);
      u32x2 ov;
      ov.x = pk2(O[dvt][4 * g + 0] * inv * bflo(gv.x), O[dvt][4 * g + 1] * inv * bfhi(gv.x));
      ov.y = pk2(O[dvt][4 * g + 2] * inv * bflo(gv.y), O[dvt][4 * g + 3] * inv * bfhi(gv.y));
      *(u32x2*)(op + dv) = ov;
    }
}

template <int DQK, bool WIN, bool FAST>
__device__ __forceinline__ void attn_item2(const Params& P, const int layer, const int b, const int head_in, const int qblk, LAS char* lds) {
  constexpr int KS = DQK / 16;
  constexpr int PK = DQK * 2 + 16;
  constexpr int PV = 192;
  constexpr int KTILE = 64 * PK, VTILE = 64 * PV;
  constexpr int KCH = DQK / 8;
  constexpr int NKL = 64 * KCH / 256;
  const int t = tid_opaque(), lane = t & 63, r = lane & 31, h = lane >> 5;
  const int w = __builtin_amdgcn_readfirstlane(t >> 6);
  const int q0 = WIN ? qblk * 64 : qblk * 256;
  const int head = WIN ? head_in * 4 + w : head_in;
  const bf16_t *Qp, *Kp, *Vp;
  if (WIN) {
    const int kvh = head_in;
    Qp = P.Qa + (size_t)(b * 8 + head) * SEQ * 64; Kp = P.Ka + (size_t)(b * 2 + kvh) * SEQ * 64; Vp = P.Va + (size_t)(b * 2 + kvh) * SEQ * 64;
  } else {
    Qp = P.Qb + (size_t)(b * 8 + head) * SEQ * 96; Kp = P.Kb + (size_t)(b * 8 + head) * SEQ * 96; Vp = P.Vb + (size_t)(b * 8 + head) * SEQ * 64;
  }
  const int klo = WIN ? (q0 >= 128 ? q0 - 128 : 0) : 0;
  const int khi = WIN ? (q0 + 192 <= SEQ ? q0 + 192 : SEQ) : SEQ;
  const int ntl = (khi - klo) >> 6;
  const int wq0 = WIN ? q0 : q0 + w * 64;
  bf16x8 qf[2][KS];
#pragma unroll
  for (int qt = 0; qt < 2; ++qt) {
    const bf16_t* qrow = Qp + (size_t)(wq0 + qt * 32 + r) * DQK + h * 8;
#pragma unroll
    for (int ks = 0; ks < KS; ++ks) qf[qt][ks] = *(const bf16x8*)(qrow + ks * 16);
  }
  f32x16 O[2][2];
#pragma unroll
  for (int e = 0; e < 16; ++e) { O[0][0][e] = 0.f; O[0][1][e] = 0.f; O[1][0][e] = 0.f; O[1][1][e] = 0.f; }
  float m[2], l[2];
  {
    const float sink2 = WIN ? P.a_sink[layer * 8 + head] * LOG2E : 0.f;
#pragma unroll
    for (int qt = 0; qt < 2; ++qt) {
      if (FAST) { m[qt] = 0.f; l[qt] = (WIN && h == 0) ? __builtin_amdgcn_exp2f(sink2) : 0.f; }
      else if (WIN) { m[qt] = sink2; l[qt] = (h == 0) ? 1.f : 0.f; }
      else { m[qt] = -1e30f; l[qt] = 0.f; }
    }
  }
  u32x4 rk[NKL], rv[2];
  const char* Kg = (const char*)(Kp + (size_t)klo * DQK);
  const char* Vg = (const char*)(Vp + (size_t)klo * 64);
  int koff[NKL], voff[2];
#pragma unroll
  for (int i = 0; i < NKL; ++i) { const int c = t + 256 * i; koff[i] = (c / KCH) * PK + (c % KCH) * 16; }
#pragma unroll
  for (int i = 0; i < 2; ++i) { const int c = t + 256 * i; voff[i] = (c >> 3) * PV + (c & 7) * 16; }
  const int i16 = lane & 15, tq = i16 >> 2, tp = i16 & 3, blk = (lane >> 4) & 1;
  const int troff = (4 * h + tq) * PV + blk * 32 + tp * 8;
#pragma unroll
  for (int i = 0; i < NKL; ++i) rk[i] = *(const u32x4*)(Kg + (unsigned)((t + 256 * i) * 16));
#pragma unroll
  for (int i = 0; i < 2; ++i) rv[i] = *(const u32x4*)(Vg + (unsigned)((t + 256 * i) * 16));
#pragma unroll
  for (int i = 0; i < NKL; ++i) *(LAS u32x4*)(lds + koff[i]) = rk[i];
#pragma unroll
  for (int i = 0; i < 2; ++i) *(LAS u32x4*)(lds + KTILE + voff[i]) = rv[i];
  __syncthreads();

  for (int kt = 0; kt < ntl; ++kt) {
    const bool more = (kt + 1 < ntl);
    if (more) {
      const char* kg = Kg + (size_t)(kt + 1) * 64 * DQK * 2;
      const char* vg = Vg + (size_t)(kt + 1) * 64 * 64 * 2;
#pragma unroll
      for (int i = 0; i < NKL; ++i) rk[i] = *(const u32x4*)(kg + (unsigned)((t + 256 * i) * 16));
#pragma unroll
      for (int i = 0; i < 2; ++i) rv[i] = *(const u32x4*)(vg + (unsigned)((t + 256 * i) * 16));
    }
    LAS const char* sK = lds + (kt & 1) * (KTILE + VTILE);
    LAS const char* sV = sK + KTILE;
    const int kb = klo + kt * 64;
    const bool active = !WIN || ((kb + 63 >= wq0 - 128) && (kb <= wq0 + 63 + 128));
    if (active) {
#pragma unroll
      for (int sub = 0; sub < 2; ++sub) {
        f32x16 S[2];
#pragma unroll
        for (int qt = 0; qt < 2; ++qt) {
#pragma unroll
          for (int e = 0; e < 16; ++e) S[qt][e] = 0.f;
#pragma unroll
          for (int ks = 0; ks < KS; ++ks) {
            const bf16x8 kf = *(LAS const bf16x8*)(sK + (sub * 32 + r) * PK + ks * 32 + h * 16);
            S[qt] = MFMA32(kf, qf[qt][ks], S[qt]);
          }
        }
#pragma unroll
        for (int qt = 0; qt < 2; ++qt) {
          if (WIN) {
            const int dq = kb + sub * 32 - (wq0 + qt * 32 + r);
#pragma unroll
            for (int e = 0; e < 16; ++e) { const int d = dq + crow(e, h); if (d > 128 || d < -128) S[qt][e] = -1e30f; }
          }
          float ls = 0.f;
          if (FAST) {
#pragma unroll
            for (int e = 0; e < 16; ++e) { const float pv = __builtin_amdgcn_exp2f(S[qt][e]); S[qt][e] = pv; ls += pv; }
            l[qt] += ls;
          } else {
            float mx = S[qt][0];
#pragma unroll
            for (int e = 1; e < 16; ++e) mx = fmaxf(mx, S[qt][e]);
            mx = fmaxf(mx, shflx(mx, 32, lane));
            const float mn = fmaxf(m[qt], mx);
            const float alpha = __builtin_amdgcn_exp2f(m[qt] - mn);
            m[qt] = mn;
#pragma unroll
            for (int e = 0; e < 16; ++e) { const float pv = __builtin_amdgcn_exp2f(S[qt][e] - mn); S[qt][e] = pv; ls += pv; }
            l[qt] = l[qt] * alpha + ls;
#pragma unroll
            for (int e = 0; e < 16; ++e) { O[qt][0][e] *= alpha; O[qt][1][e] *= alpha; }
          }
#pragma unroll
          for (int s2 = 0; s2 < 2; ++s2) {
            u32x4 pw;
            pw.x = pk2(S[qt][8 * s2 + 0], S[qt][8 * s2 + 1]); pw.y = pk2(S[qt][8 * s2 + 2], S[qt][8 * s2 + 3]);
            pw.z = pk2(S[qt][8 * s2 + 4], S[qt][8 * s2 + 5]); pw.w = pk2(S[qt][8 * s2 + 6], S[qt][8 * s2 + 7]);
            const bf16x8 pf = __builtin_bit_cast(bf16x8, pw);
#pragma unroll
            for (int dvt = 0; dvt < 2; ++dvt) {
              LAS const char* va = sV + (sub * 32 + s2 * 16) * PV + dvt * 64 + troff;
              const s16x4 lo = __builtin_amdgcn_ds_read_tr16_b64_v4i16((LAS s16x4*)(va));
              const s16x4 hi = __builtin_amdgcn_ds_read_tr16_b64_v4i16((LAS s16x4*)(va + 8 * PV));
              const bf16x8 vf = __builtin_shufflevector(lo, hi, 0, 1, 2, 3, 4, 5, 6, 7);
              O[qt][dvt] = MFMA32(vf, pf, O[qt][dvt]);
            }
          }
        }
      }
    }
    if (more) {
      LAS char* dK = lds + ((kt + 1) & 1) * (KTILE + VTILE);
#pragma unroll
      for (int i = 0; i < NKL; ++i) *(LAS u32x4*)(dK + koff[i]) = rk[i];
#pragma unroll
      for (int i = 0; i < 2; ++i) *(LAS u32x4*)(dK + KTILE + voff[i]) = rv[i];
    }
    __syncthreads();
  }
#pragma unroll
  for (int qt = 0; qt < 2; ++qt) {
    float lt = l[qt];
    lt += shflx(lt, 32, lane);
    const float inv = 1.0f / lt;
    const int tok = b * SEQ + wq0 + qt * 32 + r;
    const int colb = (WIN ? 0 : 512) + head * 64;
    const bf16_t* gp = P.G + (size_t)tok * 1024 + colb;
    bf16_t* op = P.mix + (size_t)tok * 1024 + colb;
#pragma unroll
    for (int dvt = 0; dvt < 2; ++dvt)
#pragma unroll
      for (int g = 0; g < 4; g += 2) {
        u32x2 pk[2];
#pragma unroll
        for (int q = 0; q < 2; ++q) {
          const int dv = dvt * 32 + 8 * (g + q) + 4 * h;
          const u32x2 gv = *(const u32x2*)(gp + dv);
          pk[q].x = pk2(O[qt][dvt][4 * (g + q) + 0] * inv * bflo(gv.x), O[qt][dvt][4 * (g + q) + 1] * inv * bfhi(gv.x));
          pk[q].y = pk2(O[qt][dvt][4 * (g + q) + 2] * inv * bflo(gv.y), O[qt][dvt][4 * (g + q) + 3] * inv * bfhi(gv.y));
        }
        const auto rx = __builtin_amdgcn_permlane32_swap(pk[0].x, pk[1].x, false, false);
        const auto ry = __builtin_amdgcn_permlane32_swap(pk[0].y, pk[1].y, false, false);
        u32x4 ov; ov.x = rx[0]; ov.y = ry[0]; ov.z = rx[1]; ov.w = ry[1];
        *(u32x4*)(op + dvt * 32 + 8 * g + 8 * h) = ov;
      }
  }
}

__device__ __forceinline__ void conv_w(bf16_t* __restrict__ dst, const float* __restrict__ src, const float* __restrict__ g, const int K, const int Nsrc, const int Ndst, const int mode,
                                       const int gtid, const int gsz) {
  const int items = Ndst * (K >> 3);
  for (int it = gtid; it < items; it += gsz) {
    const int n = it % Ndst, kc = it / Ndst;
    int col;
    if (mode == 0) col = n;
    else if (mode == 1) col = n < 1920 ? n : (n < 2432 ? n + 32 : (n < 2464 ? n - 512 : -1));
    else { const int hh = n >> 7, c = n & 127; col = c < 96 ? hh * 96 + c : -1; }
    float v[8];
#pragma unroll
    for (int j = 0; j < 8; ++j) {
      const int k = kc * 8 + j;
      float val = 0.f;
      if (col >= 0) { val = src[(size_t)k * Nsrc + col]; if (g) val *= g[k]; }
      v[j] = val;
    }
    *(u32x4*)(dst + (size_t)n * K + kc * 8) = pk8(v[0], v[1], v[2], v[3], v[4], v[5], v[6], v[7]);
  }
}

__device__ __forceinline__ void phase0(const Params& P) {
  const int gtid = blockIdx.x * 256 + tid_opaque(), gsz = gridDim.x * 256;
  for (int l = 0; l < 4; ++l) {
    conv_w(P.WinT + (size_t)l * 2560 * 1024, P.w_in + (size_t)l * 1024 * 2464, P.norm_g + l * 1024, 1024, 2464, 2560, 1, gtid, gsz);
    conv_w(P.WuqT + (size_t)l * 1024 * 384, P.b_w_uq + (size_t)l * 384 * 768, P.b_cq_norm + l * 384, 384, 768, 1024, 2, gtid, gsz);
    conv_w(P.WukvT + (size_t)l * 1024 * 256, P.b_w_ukv + (size_t)l * 256 * 1024, P.b_ckv_norm + l * 256, 256, 1024, 1024, 0, gtid, gsz);
    conv_w(P.WoutT + (size_t)l * 1024 * 1024, P.w_out + (size_t)l * 1024 * 1024, nullptr, 1024, 1024, 1024, 0, gtid, gsz);
    conv_w(P.WgT + (size_t)l * 1024 * 1024, P.ple_w_gate + (size_t)l * 1024 * 1024, P.ple_g + l * 1024, 1024, 1024, 1024, 0, gtid, gsz);
    conv_w(P.WpT + (size_t)l * 1024 * 256, P.ple_w_proj + (size_t)l * 256 * 1024, nullptr, 256, 1024, 1024, 0, gtid, gsz);
  }
  {
    const int gw = gtid >> 6, nw = gsz >> 6, lane = threadIdx.x & 63;
    for (int row0 = gw; row0 < T_TOK; row0 += 4 * nw) {
      f32x4 a[4][4];
#pragma unroll
      for (int q = 0; q < 4; ++q) {
        const int row = row0 + q * nw;
        const float* xr = P.x + (size_t)(row < T_TOK ? row : row0) * 1024;
#pragma unroll
        for (int i = 0; i < 4; ++i) a[q][i] = *(const f32x4*)(xr + i * 256 + lane * 4);
      }
#pragma unroll
      for (int q = 0; q < 4; ++q) {
        const int row = row0 + q * nw;
        if (row < T_TOK) {
          float ss = 0.f;
#pragma unroll
          for (int i = 0; i < 4; ++i) {
            ss += a[q][i].x * a[q][i].x + a[q][i].y * a[q][i].y + a[q][i].z * a[q][i].z + a[q][i].w * a[q][i].w;
            u32x2 o; o.x = pk2(a[q][i].x, a[q][i].y); o.y = pk2(a[q][i].z, a[q][i].w);
            *(u32x2*)(P.xbA + (size_t)row * 1024 + i * 256 + lane * 4) = o;
          }
          ss += shflx(ss, 32, lane); ss += shflx(ss, 16, lane); ss += shflx(ss, 8, lane); ss += shflx(ss, 4, lane); ss += shflx(ss, 2, lane); ss += shflx(ss, 1, lane);
          if (lane < 8) P.ssqX[row * 8 + lane] = (lane == 0) ? ss : 0.f;
        }
      }
    }
  }
  if (blockIdx.x == 0 && threadIdx.x < 4) {
    const int l = threadIdx.x;
    float gq = 0.f, gk = 0.f, aq = 0.f, ak = 0.f, sk = 0.f;
    for (int i = 0; i < 96; ++i) { gq = fmaxf(gq, fabsf(P.b_q_norm[l * 96 + i])); gk = fmaxf(gk, fabsf(P.b_k_norm[l * 96 + i])); }
    for (int i = 0; i < 64; ++i) { aq = fmaxf(aq, fabsf(P.a_q_norm[l * 64 + i])); ak = fmaxf(ak, fabsf(P.a_k_norm[l * 64 + i])); }
    for (int i = 0; i < 8; ++i) sk = fmaxf(sk, fabsf(P.a_sink[l * 8 + i]));
    const float bb = QB_SCALE * 96.f * gq * gk, ba = QA_SCALE * 64.f * aq * ak;
    P.flags[l] = (bb <= 60.f) ? 1 : 0;
    P.flags[4 + l] = (ba <= 60.f && sk * LOG2E <= 60.f) ? 1 : 0;
  }
  for (int idx = gtid; idx < T_TOK * 32; idx += gsz) {
    const int tok = idx >> 5, i = idx & 31;
    const float ang = (float)P.pos[tok] * P.invA[i];
    const double rev = (double)ang * 0.15915494309189535; const float fr = (float)(rev - rint(rev));
    P.cosA[idx] = __builtin_amdgcn_cosf(fr); P.sinA[idx] = __builtin_amdgcn_sinf(fr);
  }
  for (int idx = gtid; idx < T_TOK * 16; idx += gsz) {
    const int tok = idx >> 4, i = idx & 15;
    const float ang = (float)P.pos[tok] * P.invB[i];
    const double rev = (double)ang * 0.15915494309189535; const float fr = (float)(rev - rint(rev));
    P.cosB[idx] = __builtin_amdgcn_cosf(fr); P.sinB[idx] = __builtin_amdgcn_sinf(fr);
  }
}


#define XB_TMO      128
#define XB_XCNT(j)  (256  + 64 * (j))
#define XB_XSUB(j)  (1280 + 64 * (j))
#define XB_XGEN(j)  (2304 + 64 * (j))
#define XB_TOP      3328
#define XB_TOPGEN   3392
#define XCD_BAR_WORDS 3456
#define XB_SPIN_CAP (1u << 20)
__device__ __forceinline__ unsigned xb_ld(unsigned* p)              { return __hip_atomic_load(p, __ATOMIC_RELAXED, __HIP_MEMORY_SCOPE_AGENT); }
__device__ __forceinline__ unsigned xb_add(unsigned* p, unsigned v) { return __hip_atomic_fetch_add(p, v, __ATOMIC_RELAXED, __HIP_MEMORY_SCOPE_AGENT); }
__device__ __forceinline__ unsigned xb_xcc_id() { return (unsigned)__builtin_amdgcn_s_getreg((3 << 11) | 20) & 0xFu; }
#define XB_SPIN(cond, bar) do { unsigned _sp = 0; while (cond) { __builtin_amdgcn_s_sleep(1); \
    if ((++_sp & 255u) == 0u) { if (xb_ld(&(bar)[XB_TMO])) break; if (_sp > XB_SPIN_CAP) { atomicAdd(&(bar)[XB_TMO], 1u); break; } } } } while (0)
struct XcdBarrier { unsigned* bar; unsigned x; volatile LAS unsigned* st; };
__device__ __forceinline__ XcdBarrier xcd_barrier_post(unsigned* bar, volatile LAS unsigned* st) {
  XcdBarrier b; b.bar = bar; b.x = xb_xcc_id(); b.st = st;
  if (threadIdx.x == 0) (void)xb_add(&bar[XB_XCNT(b.x)], 1u);
  return b;
}
__device__ __forceinline__ void xcd_barrier_complete(unsigned* bar, unsigned x, unsigned& nloc, unsigned& nx) {
  const unsigned G = gridDim.x * gridDim.y * gridDim.z;
  unsigned sum, cnt, mine, sp = 0u;
  for (;;) {
    sum = 0u; cnt = 0u; mine = 0u;
#pragma unroll
    for (unsigned j = 0; j < 16; ++j) { const unsigned c = xb_ld(&bar[XB_XCNT(j)]); sum += c; cnt += (c > 0u) ? 1u : 0u; mine = (j == x) ? c : mine; }
    if (sum == G) break;
    __builtin_amdgcn_s_sleep(1);
    if ((++sp & 255u) == 0u) { if (xb_ld(&bar[XB_TMO])) break; if (sp > XB_SPIN_CAP) { atomicAdd(&bar[XB_TMO], 1u); break; } }
  }
  nloc = mine > 0u ? mine : 1u; nx = cnt > 0u ? cnt : 1u;
}
__device__ __forceinline__ void xcd_barrier(const XcdBarrier& b) {
  asm volatile("s_waitcnt vmcnt(0)" ::: "memory");
  __syncthreads();
  if (threadIdx.x == 0) {
    unsigned* bar = b.bar;
    unsigned bx = __builtin_amdgcn_readfirstlane(b.x);
    asm volatile("" : "+s"(bx));
    __builtin_amdgcn_s_waitcnt(0);
    unsigned nloc = b.st[0], nx = b.st[1];
    if (nloc == 0u) { xcd_barrier_complete(bar, bx, nloc, nx); b.st[0] = nloc; b.st[1] = nx; }
    const unsigned old = xb_add(&bar[XB_XSUB(bx)], 1u);
    const unsigned gen = old / nloc;
    if (old + 1u == (gen + 1u) * nloc) {
      __builtin_amdgcn_fence(__ATOMIC_RELEASE, "agent");
      asm volatile("s_waitcnt vmcnt(0)" ::: "memory");
      const unsigned og = xb_add(&bar[XB_TOP], 1u);
      const unsigned tg = og / nx;
      if (og + 1u == (tg + 1u) * nx) xb_add(&bar[XB_TOPGEN], 1u);
      else XB_SPIN(xb_ld(&bar[XB_TOPGEN]) == tg, bar);
      __builtin_amdgcn_fence(__ATOMIC_ACQUIRE, "agent");
      xb_add(&bar[XB_XGEN(bx)], 1u);
      asm volatile("s_waitcnt vmcnt(0)" ::: "memory");
    } else {
      XB_SPIN(xb_ld(&bar[XB_XGEN(bx)]) == gen, bar);
      __builtin_amdgcn_fence(__ATOMIC_ACQUIRE, "agent");
      asm volatile("s_waitcnt vmcnt(0)" ::: "memory");
    }
  }
  __syncthreads();
}

typedef const __attribute__((address_space(4))) Params* KargPtr;
#define KARGS(name) KargPtr name##_p = (KargPtr)__builtin_amdgcn_kernarg_segment_ptr(); asm volatile("" : "+s"(name##_p)); const Params& name = *(const Params*)name##_p
__global__ void __launch_bounds__(256, 2) hybrid_fwd(const Params PK) {
  __shared__ __attribute__((aligned(16))) char smem[73728];
  LAS char* lds = (LAS char*)smem;
  __shared__ uint4 xb_words;
  cg::grid_group grid = cg::this_grid();
  if (threadIdx.x == 0) xb_words = make_uint4(0u, 0u, 0u, 0u);
  __syncthreads();
  const XcdBarrier xb = xcd_barrier_post(PK.bar, (volatile LAS unsigned*)&xb_words);
  { KARGS(P); phase0(P); }
  if (PK.bar == nullptr) grid.sync();
  xcd_barrier(xb);
  for (int layer = 0; layer < 4; ++layer) {
    int tile, tm, tn;
    {
    KARGS(P);
    for (int it = 0; next_tile2(it, 10, tm, tn); ++it)
      gemm2_tile<1>(P, layer, P.xbA, P.WinT + (size_t)layer * 2560 * 1024, 1024, tm, tn, lds);
    }
    xcd_barrier(xb);
    {
    KARGS(P);
    for (int it = 0; next_tile2(it, 4, tm, tn); ++it)
      gemm2_tile<2>(P, layer, P.cq, P.WuqT + (size_t)layer * 1024 * 384, 384, tm, tn, lds);
    for (int it = 0; next_tile2(it, 4, tm, tn); ++it)
      gemm2_tile<3>(P, layer, P.ckv, P.WukvT + (size_t)layer * 1024 * 256, 256, tm, tn, lds);
    }
    xcd_barrier(xb);
    {
    KARGS(P);
    {
      const float* ps = P.p + (size_t)layer * T_TOK * 256;
      int zb; asm volatile("s_mov_b32 %0, 0" : "=s"(zb));
      const int gtid = ((int)blockIdx.x + zb) * 256 + (int)threadIdx.x, gsz = gridDim.x * 256;
      for (int c0 = gtid; c0 < T_TOK * 32; c0 += 4 * gsz) {
        f32x4 a[4][2];
#pragma unroll
        for (int q = 0; q < 4; ++q) { const int c = c0 + q * gsz; const float* src = ps + (size_t)(c < T_TOK * 32 ? c : c0) * 8; a[q][0] = *(const f32x4*)src; a[q][1] = *(const f32x4*)(src + 4); }
#pragma unroll
        for (int q = 0; q < 4; ++q) { const int c = c0 + q * gsz; if (c < T_TOK * 32) *(u32x4*)(P.pb + (size_t)c * 8) = pk8(a[q][0].x, a[q][0].y, a[q][0].z, a[q][0].w, a[q][1].x, a[q][1].y, a[q][1].z, a[q][1].w); }
      }
    }
    if (P.flags[layer]) { for (int it = 0; next_tile(it, 1024, tile); ++it) attn_item2<96, false, true>(P, layer, tile >> 7, (tile >> 4) & 7, tile & 15, lds); }
    else { for (int it = 0; next_tile(it, 2048, tile); ++it) attn_item<96, false>(P, layer, tile >> 8, (tile >> 5) & 7, tile & 31, lds); }
    if (P.flags[4 + layer]) { for (int it = 0; next_tile(it, 1024, tile); ++it) attn_item2<64, true, true>(P, layer, tile >> 7, (tile >> 6) & 1, tile & 63, lds); }
    else { for (int it = 0; next_tile(it, 2048, tile); ++it) attn_item<64, true>(P, layer, tile >> 8, (tile >> 5) & 7, tile & 31, lds); }
    }
    xcd_barrier(xb);
    {
    KARGS(P);
    for (int it = 0; next_tile2(it, 4, tm, tn); ++it)
      gemm2_tile<4>(P, layer, P.mix, P.WoutT + (size_t)layer * 1024 * 1024, 1024, tm, tn, lds);
    for (int it = 0; next_tile2(it, 4, tm, tn); ++it)
      gemm2_tile<5>(P, layer, P.pb, P.WpT + (size_t)layer * 1024 * 256, 256, tm, tn, lds);
    }
    xcd_barrier(xb);
    {
    KARGS(P);
    for (int it = 0; next_tile2(it, 4, tm, tn); ++it)
      gemm2_tile<6>(P, layer, P.xbB, P.WgT + (size_t)layer * 1024 * 1024, 1024, tm, tn, lds);
    }
    xcd_barrier(xb);
  }
}

extern "C" void kernel_launch(void* const* d_in, const int* in_sizes, int n_in, void* d_out, int out_size, void* d_ws, size_t ws_size, hipStream_t stream) {
  static Params P;
  memset(&P, 0, sizeof(P));
  P.x = (const float*)d_in[0]; P.p = (const float*)d_in[1]; P.pos = (const int*)d_in[2];
  P.norm_g = (const float*)d_in[3]; P.w_in = (const float*)d_in[4]; P.a_q_norm = (const float*)d_in[5]; P.a_k_norm = (const float*)d_in[6]; P.a_sink = (const float*)d_in[7];
  P.b_cq_norm = (const float*)d_in[8]; P.b_ckv_norm = (const float*)d_in[9]; P.b_w_uq = (const float*)d_in[10]; P.b_w_ukv = (const float*)d_in[11];
  P.b_q_norm = (const float*)d_in[12]; P.b_k_norm = (const float*)d_in[13]; P.w_out = (const float*)d_in[14]; P.ple_g = (const float*)d_in[15];
  P.ple_w_gate = (const float*)d_in[16]; P.ple_w_proj = (const float*)d_in[17];
  P.out = (float*)d_out;
  char* ws = (char*)d_ws; size_t off = 0;
  auto take = [&](size_t bytes) { char* p = ws + off; off += (bytes + 255) & ~(size_t)255; return p; };
  const size_t T = T_TOK;
  P.WinT = (bf16_t*)take((size_t)4 * 2560 * 1024 * 2);
  P.WuqT = (bf16_t*)take((size_t)4 * 1024 * 384 * 2);
  P.WukvT = (bf16_t*)take((size_t)4 * 1024 * 256 * 2);
  P.WoutT = (bf16_t*)take((size_t)4 * 1024 * 1024 * 2);
  P.WgT = (bf16_t*)take((size_t)4 * 1024 * 1024 * 2);
  P.WpT = (bf16_t*)take((size_t)4 * 1024 * 256 * 2);
  P.cosA = (float*)take(T * 32 * 4); P.sinA = (float*)take(T * 32 * 4);
  P.cosB = (float*)take(T * 16 * 4); P.sinB = (float*)take(T * 16 * 4);
  P.xbA = (bf16_t*)take(T * 1024 * 2); P.xbB = (bf16_t*)take(T * 1024 * 2);
  P.Qa = (bf16_t*)take(T * 512 * 2); P.Ka = (bf16_t*)take(T * 128 * 2); P.Va = (bf16_t*)take(T * 128 * 2);
  P.G = (bf16_t*)take(T * 1024 * 2);
  {
    char* mixr = take(T * 1024 * 2);
    P.mix = (bf16_t*)mixr; P.cq = (bf16_t*)mixr; P.ckv = (bf16_t*)(mixr + T * 384 * 2); P.bkr = (float*)(mixr + T * 384 * 2 + T * 256 * 2);
  }
  {
    char* qk = take(T * 768 * 2 * 2);
    P.Qb = (bf16_t*)qk; P.Kb = (bf16_t*)(qk + T * 768 * 2); P.pe = (bf16_t*)qk;
  }
  P.Vb = (bf16_t*)take(T * 512 * 2);
  P.pb = (bf16_t*)take(T * 256 * 2);
  P.bar = (unsigned*)take(XCD_BAR_WORDS * 4);
  P.flags = (int*)take(256);
  P.ssqX = (float*)take(T * 8 * 4); P.ssq1 = (float*)take(T * 8 * 4); P.ssqcq = (float*)take(T * 4 * 4); P.ssqckv = (float*)take(T * 2 * 4);
  for (int i = 0; i < 32; ++i) P.invA[i] = (float)pow(10000.0, -(double)i * 2.0 / 64.0);
  for (int i = 0; i < 16; ++i) P.invB[i] = (float)pow(10000.0, -(double)i * 2.0 / 32.0);
  if (off > ws_size) fprintf(stderr, "workspace too small: need %zu have %zu\n", off, ws_size);

  static int grid_blocks = 0;
  if (!grid_blocks) {
    int dev = 0, cus = 0, per_cu = 0;
    (void)hipGetDevice(&dev);
    (void)hipDeviceGetAttribute(&cus, hipDeviceAttributeMultiprocessorCount, dev);
    (void)hipOccupancyMaxActiveBlocksPerMultiprocessor(&per_cu, hybrid_fwd, 256, 0);
    if (per_cu > 2) per_cu = 2;
    if (per_cu < 1) per_cu = 1;
    grid_blocks = cus * per_cu;
    grid_blocks &= ~7;
  }
  (void)hipMemsetAsync(P.bar, 0, XCD_BAR_WORDS * 4, stream);
  void* args[] = {(void*)&P};
  hipError_t e = hipLaunchCooperativeKernel((const void*)hybrid_fwd, dim3(grid_blocks), dim3(256), args, 0, stream);
  if (e != hipSuccess) fprintf(stderr, "cooperative launch failed: %s (grid %d)\n", hipGetErrorString(e), grid_blocks);
}
```

```cpp
#include <hip/hip_runtime.h>
#include <hip/hip_cooperative_groups.h>
#include <stdint.h>
#include <math.h>
#include <stdio.h>
#include <string.h>
namespace cg = cooperative_groups;

#define T_TOK 32768
#define SEQ 4096
#define LAS __attribute__((address_space(3)))
#define LOG2E 1.4426950408889634f
#define QA_SCALE (0.125f * LOG2E)
#define QB_SCALE (0.10206207261596575f * LOG2E)

typedef short bf16x8 __attribute__((ext_vector_type(8)));
typedef short s16x4 __attribute__((ext_vector_type(4)));
typedef float f32x16 __attribute__((ext_vector_type(16)));
typedef float f32x4 __attribute__((ext_vector_type(4)));
typedef float f32x2 __attribute__((ext_vector_type(2)));
typedef unsigned u32x4 __attribute__((ext_vector_type(4)));
typedef unsigned u32x2 __attribute__((ext_vector_type(2)));
typedef __bf16 bf2_t __attribute__((ext_vector_type(2)));
typedef unsigned short bf16_t;

#define MFMA32(a, b, c) __builtin_amdgcn_mfma_f32_32x32x16_bf16((a), (b), (c), 0, 0, 0)

struct Params {
  const float* x; const float* p; const int* pos;
  const float* norm_g; const float* w_in; const float* a_q_norm; const float* a_k_norm; const float* a_sink;
  const float* b_cq_norm; const float* b_ckv_norm; const float* b_w_uq; const float* b_w_ukv; const float* b_q_norm; const float* b_k_norm;
  const float* w_out; const float* ple_g; const float* ple_w_gate; const float* ple_w_proj;
  float* out;
  bf16_t* WinT; bf16_t* WuqT; bf16_t* WukvT; bf16_t* WoutT; bf16_t* WgT; bf16_t* WpT;
  float* cosA; float* sinA; float* cosB; float* sinB;
  bf16_t* xbA; bf16_t* xbB; bf16_t* Qa; bf16_t* Ka; bf16_t* Va; bf16_t* G; bf16_t* cq; bf16_t* ckv;
  bf16_t* Qb; bf16_t* Kb; bf16_t* Vb; bf16_t* mix; bf16_t* pe; bf16_t* pb;
  float* bkr; float* ssqX; float* ssq1; float* ssqcq; float* ssqckv;
  unsigned* bar; int* flags;
  float invA[32]; float invB[16];
};

__device__ __forceinline__ int crow(int e, int h) { return (e & 3) + 8 * (e >> 2) + 4 * h; }
__device__ __forceinline__ unsigned pk2(float a, float b) { f32x2 v = {a, b}; bf2_t r = __builtin_convertvector(v, bf2_t); return __builtin_bit_cast(unsigned, r); }
__device__ __forceinline__ u32x4 pk8(float a0, float a1, float a2, float a3, float a4, float a5, float a6, float a7) {
  u32x4 r; r.x = pk2(a0, a1); r.y = pk2(a2, a3); r.z = pk2(a4, a5); r.w = pk2(a6, a7); return r;
}
__device__ __forceinline__ float bflo(unsigned u) { return __uint_as_float(u << 16); }
__device__ __forceinline__ float bfhi(unsigned u) { return __uint_as_float(u & 0xffff0000u); }
__device__ __forceinline__ float sigmoidf_(float x) { return __builtin_amdgcn_rcpf(1.0f + __expf(-x)); }

template <int CTRL> __device__ __forceinline__ float dppf(float v) { return __int_as_float(__builtin_amdgcn_update_dpp(0, __float_as_int(v), CTRL, 0xF, 0xF, true)); }
__device__ __forceinline__ float sum8(float v) { v += dppf<0xB1>(v); v += dppf<0x4E>(v); v += dppf<0x141>(v); return v; }
__device__ __forceinline__ float sum16(float v) { v = sum8(v); v += dppf<0x140>(v); return v; }
__device__ __forceinline__ float lane_xor2(float v) { return dppf<0x4E>(v); }
__device__ __forceinline__ float lane_xor4(float v) { return dppf<0x1B>(dppf<0x141>(v)); }
__device__ __forceinline__ float shflx(float v, int mask, int lane) { return __int_as_float(__builtin_amdgcn_ds_bpermute((lane ^ mask) << 2, __float_as_int(v))); }
__device__ __forceinline__ int tid_opaque() { int z; asm volatile("s_mov_b32 %0, 0" : "=s"(z)); return (int)threadIdx.x + z; }

__device__ __forceinline__ bool next_tile(int it, int ntiles, int& tile) {
  const int G8 = gridDim.x >> 3, b = blockIdx.x;
  const int per = ntiles >> 3;
  const int idx = it * G8 + (b >> 3);
  if (idx >= per) return false;
  tile = (b & 7) * per + idx;
  return true;
}

__device__ __forceinline__ bool next_tile2(int it, int nt2, int& m, int& n) {
  const int G8 = gridDim.x >> 3, b = blockIdx.x;
  const int idx = it * G8 + (b >> 3);
  if (idx >= 32 * nt2) return false;
  const int g = idx >> 6, j = idx & 63;
  m = 32 * (b & 7) + (j >> 1); n = 2 * g + (j & 1);
  return true;
}

__device__ __forceinline__ void norm96_rope_store(float (&v)[8], const int lane, const int chunk, const float* __restrict__ gain, const float* __restrict__ cosB, const float* __restrict__ sinB,
                                                  const int tok, const float scale, bf16_t* __restrict__ dst) {
  float ss = 0.f;
#pragma unroll
  for (int j = 0; j < 8; ++j) ss += v[j] * v[j];
  ss = sum16(ss);
  const float rinv = rsqrtf(ss * (1.f / 96.f) + 1e-6f);
  const int cc = chunk < 12 ? chunk : 0;
  float vn[8], o[8];
#pragma unroll
  for (int j = 0; j < 8; ++j) vn[j] = v[j] * rinv * gain[cc * 8 + j];
  const bool isrope = (chunk >= 8) && (chunk < 12);
  const bool first = chunk < 10;
  const int fi = (chunk & 1) * 8;
#pragma unroll
  for (int j = 0; j < 8; ++j) {
    const float pr = lane_xor2(vn[j]);
    const float c = cosB[tok * 16 + fi + j], s = sinB[tok * 16 + fi + j];
    const float rv = first ? (vn[j] * c - pr * s) : (vn[j] * c + pr * s);
    o[j] = (isrope ? rv : vn[j]) * scale;
  }
  if (chunk < 12) *(u32x4*)(dst + chunk * 8) = pk8(o[0], o[1], o[2], o[3], o[4], o[5], o[6], o[7]);
}

typedef float f32x4acc __attribute__((ext_vector_type(4)));
#define MFMA16(a, b, c) __builtin_amdgcn_mfma_f32_16x16x32_bf16((a), (b), (c), 0, 0, 0)
template <bool EARLYBAR>
__device__ __forceinline__ void gemm2_main(const bf16_t* __restrict__ Ag, const bf16_t* __restrict__ Bg, const int K, const int m0, const int n0,
                                           LAS char* lds, f32x4acc (&acc)[4][8]) {
  const int t = tid_opaque(), lane = t & 63, w = t >> 6, fr = lane & 15, fq = lane >> 4, wr = w >> 1, wc = w & 1;
  const int lrow = t >> 3, lc8 = t & 7;
  const char* Ab = (const char*)(Ag + (size_t)m0 * K);
  const char* Bb = (const char*)(Bg + (size_t)n0 * K);
  const unsigned toff = (unsigned)(lrow * K + lc8 * 8) * 2u;
  const unsigned rsb = (unsigned)K * 64u;
  u32x4 ra[4], rb[8];
#pragma unroll
  for (int i = 0; i < 4; ++i)
#pragma unroll
    for (int j = 0; j < 8; ++j) acc[i][j] = (f32x4acc){0.f, 0.f, 0.f, 0.f};
  const int nk = K >> 6;
  const int soff = lrow * 160 + lc8 * 16;
#pragma unroll
  for (int i = 0; i < 4; ++i) ra[i] = *(const u32x4*)(Ab + (toff + i * rsb));
#pragma unroll
  for (int i = 0; i < 8; ++i) rb[i] = *(const u32x4*)(Bb + (toff + i * rsb));
  const int aoff = (wr * 64 + fr) * 160 + fq * 16;
  const int boff = 20480 + (wc * 64 + fr) * 160 + fq * 16;
  for (int kt = 0; kt < nk; ++kt) {
#pragma unroll
    for (int i = 0; i < 4; ++i) *(LAS u32x4*)(lds + i * 5120 + soff) = ra[i];
#pragma unroll
    for (int i = 0; i < 8; ++i) *(LAS u32x4*)(lds + 20480 + i * 5120 + soff) = rb[i];
    __syncthreads();
    if (kt + 1 < nk) {
      const unsigned k0 = (unsigned)(kt + 1) << 7;
#pragma unroll
      for (int i = 0; i < 4; ++i) ra[i] = *(const u32x4*)(Ab + (toff + i * rsb + k0));
#pragma unroll
      for (int i = 0; i < 8; ++i) rb[i] = *(const u32x4*)(Bb + (toff + i * rsb + k0));
    }
#pragma unroll
    for (int ks = 0; ks < 2; ++ks) {
      bf16x8 af[4];
#pragma unroll
      for (int i = 0; i < 4; ++i) af[i] = *(LAS const bf16x8*)(lds + aoff + i * 2560 + ks * 64);
#pragma unroll
      for (int hh = 0; hh < 2; ++hh) {
        bf16x8 bfr[4];
#pragma unroll
        for (int j = 0; j < 4; ++j) bfr[j] = *(LAS const bf16x8*)(lds + boff + (hh * 128 + j * 16) * 160 + ks * 64);
        if (EARLYBAR && ks == 1 && hh == 1) __syncthreads();
#pragma unroll
        for (int i = 0; i < 4; ++i)
#pragma unroll
          for (int j = 0; j < 4; ++j) acc[i][hh * 4 + j] = MFMA16(bfr[j], af[i], acc[i][hh * 4 + j]);
      }
    }
    if (!EARLYBAR) __syncthreads();
  }
}

__device__ __forceinline__ void dump_half(LAS float* C, const f32x4acc (&acc)[4][8], const int hf) {
  const int t = tid_opaque(), lane = t & 63, w = t >> 6, fr = lane & 15, fq = lane >> 4, wr = w >> 1, wc = w & 1;
#pragma unroll
  for (int i = 0; i < 4; ++i)
#pragma unroll
    for (int nj = 0; nj < 4; ++nj)
      *(LAS f32x4acc*)(C + (wr * 64 + i * 16 + fr) * 132 + wc * 64 + nj * 16 + fq * 4) = hf ? acc[i][4 + nj] : acc[i][nj];
}

struct EpiPre { f32x4 x0[8], x1[8]; u32x4 pv[8]; };
template <int SEG>
__device__ __forceinline__ void epi_prefetch(const Params& P, const int layer, const int mt, const int nt, EpiPre& pre) {
  const int t = tid_opaque(), chunk = t & 15, rsub = t >> 4;
#pragma unroll
  for (int pass = 0; pass < 8; ++pass) {
    const int tok = mt * 128 + pass * 16 + rsub;
    const float* xin = ((SEG == 8 && layer == 0) ? P.x : (const float*)P.out) + (size_t)tok * 1024 + nt * 128 + chunk * 8;
    pre.x0[pass] = *(const f32x4*)xin; pre.x1[pass] = *(const f32x4*)(xin + 4);
    if (SEG == 10) pre.pv[pass] = *(const u32x4*)(P.pe + (size_t)tok * 1024 + nt * 128 + chunk * 8);
  }
}

template <int SEG>
__device__ __forceinline__ void epi_loop(const Params& P, const int layer, const int mt, const int nt, LAS const float* C, LAS const float* rsl, const EpiPre& pre) {
  const int t = tid_opaque(), chunk = t & 15, rsub = t >> 4;
#pragma unroll
  for (int pass = 0; pass < 8; ++pass) {
    const int row = pass * 16 + rsub;
    const int tok = mt * 128 + row;
    const int b = tok >> 12, s = tok & 4095;
    const f32x4 c0 = *(LAS const f32x4*)(C + row * 132 + chunk * 8);
    const f32x4 c1 = *(LAS const f32x4*)(C + row * 132 + chunk * 8 + 4);
    float v[8] = {c0.x, c0.y, c0.z, c0.w, c1.x, c1.y, c1.z, c1.w};
    if (SEG <= 7 || SEG == 10) {
      const float rs = rsl[row];
      if (SEG != 10) {
#pragma unroll
        for (int j = 0; j < 8; ++j) v[j] *= rs;
      }
    }
    if (SEG == 1) {
      float ss = 0.f;
#pragma unroll
      for (int j = 0; j < 8; ++j) ss += v[j] * v[j];
      ss = sum8(ss);
      const float rinv = rsqrtf(ss * (1.f / 64.f) + 1e-6f);
      const int d0 = (chunk & 7) * 8;
      const float* gn = (nt < 4 ? P.a_q_norm : P.a_k_norm) + layer * 64 + d0;
      const float* cs = P.cosA + tok * 32 + (d0 & 31);
      const float* sn = P.sinA + tok * 32 + (d0 & 31);
      const f32x4 cs0 = *(const f32x4*)cs, cs1 = *(const f32x4*)(cs + 4), sn0 = *(const f32x4*)sn, sn1 = *(const f32x4*)(sn + 4);
      const float cc[8] = {cs0.x, cs0.y, cs0.z, cs0.w, cs1.x, cs1.y, cs1.z, cs1.w};
      const float sv[8] = {sn0.x, sn0.y, sn0.z, sn0.w, sn1.x, sn1.y, sn1.z, sn1.w};
      const bool first = d0 < 32;
      const float scale = nt < 4 ? QA_SCALE : 1.0f;
      float o[8];
#pragma unroll
      for (int j = 0; j < 8; ++j) {
        const float vn = v[j] * rinv * gn[j];
        const float pr = lane_xor4(vn);
        o[j] = (first ? (vn * cc[j] - pr * sv[j]) : (vn * cc[j] + pr * sv[j])) * scale;
      }
      bf16_t* dst;
      if (nt < 4) { const int head = nt * 2 + (chunk >> 3); dst = P.Qa + ((size_t)((b * 8 + head) * SEQ + s)) * 64 + d0; }
      else { const int kvh = chunk >> 3; dst = P.Ka + ((size_t)((b * 2 + kvh) * SEQ + s)) * 64 + d0; }
      *(u32x4*)dst = pk8(o[0], o[1], o[2], o[3], o[4], o[5], o[6], o[7]);
    } else if (SEG == 2) {
      const int kvh = chunk >> 3, d0 = (chunk & 7) * 8;
      *(u32x4*)(P.Va + ((size_t)((b * 2 + kvh) * SEQ + s)) * 64 + d0) = pk8(v[0], v[1], v[2], v[3], v[4], v[5], v[6], v[7]);
    } else if (SEG == 3) {
      const int colb = nt < 10 ? (nt - 6) * 128 : 512 + (nt - 15) * 128;
      float o[8];
#pragma unroll
      for (int j = 0; j < 8; ++j) o[j] = v[j] * sigmoidf_(v[j]);
      *(u32x4*)(P.G + (size_t)tok * 1024 + colb + chunk * 8) = pk8(o[0], o[1], o[2], o[3], o[4], o[5], o[6], o[7]);
    } else if (SEG == 4) {
      float ss = 0.f;
#pragma unroll
      for (int j = 0; j < 8; ++j) ss += v[j] * v[j];
      ss = sum16(ss);
      if (nt < 13) {
        *(u32x4*)(P.cq + (size_t)tok * 384 + (nt - 10) * 128 + chunk * 8) = pk8(v[0], v[1], v[2], v[3], v[4], v[5], v[6], v[7]);
        if (chunk == 0) P.ssqcq[tok * 4 + (nt - 10)] = ss;
      } else {
        *(u32x4*)(P.ckv + (size_t)tok * 256 + (nt - 13) * 128 + chunk * 8) = pk8(v[0], v[1], v[2], v[3], v[4], v[5], v[6], v[7]);
        if (chunk == 0) P.ssqckv[tok * 2 + (nt - 13)] = ss;
      }
    } else if (SEG == 5) {
      if (chunk < 4) {
        *(f32x4*)(P.bkr + (size_t)tok * 32 + chunk * 8) = (f32x4){v[0], v[1], v[2], v[3]};
        *(f32x4*)(P.bkr + (size_t)tok * 32 + chunk * 8 + 4) = (f32x4){v[4], v[5], v[6], v[7]};
      }
    } else if (SEG == 6) {
#pragma unroll
      for (int j = 0; j < 8; ++j) v[j] = (chunk < 12) ? v[j] : 0.f;
      norm96_rope_store(v, t & 63, chunk, P.b_q_norm + layer * 96, P.cosB, P.sinB, tok, QB_SCALE, P.Qb + ((size_t)((b * 8 + nt) * SEQ + s)) * 96);
    } else if (SEG == 7) {
      if (chunk >= 8) *(u32x4*)(P.Vb + ((size_t)((b * 8 + nt) * SEQ + s)) * 64 + (chunk - 8) * 8) = pk8(v[0], v[1], v[2], v[3], v[4], v[5], v[6], v[7]);
      if (chunk >= 8) {
        if (chunk < 12) {
          const f32x4 k0 = *(const f32x4*)(P.bkr + (size_t)tok * 32 + (chunk - 8) * 8);
          const f32x4 k1 = *(const f32x4*)(P.bkr + (size_t)tok * 32 + (chunk - 8) * 8 + 4);
          v[0] = k0.x; v[1] = k0.y; v[2] = k0.z; v[3] = k0.w; v[4] = k1.x; v[5] = k1.y; v[6] = k1.z; v[7] = k1.w;
        } else {
#pragma unroll
          for (int j = 0; j < 8; ++j) v[j] = 0.f;
        }
      }
      norm96_rope_store(v, t & 63, chunk, P.b_k_norm + layer * 96, P.cosB, P.sinB, tok, 1.0f, P.Kb + ((size_t)((b * 8 + nt) * SEQ + s)) * 96);
    } else if (SEG == 8) {
      const f32x4 x0 = pre.x0[pass], x1 = pre.x1[pass];
      v[0] += x0.x; v[1] += x0.y; v[2] += x0.z; v[3] += x0.w; v[4] += x1.x; v[5] += x1.y; v[6] += x1.z; v[7] += x1.w;
      float ss = 0.f;
#pragma unroll
      for (int j = 0; j < 8; ++j) ss += v[j] * v[j];
      ss = sum16(ss);
      float* o = P.out + (size_t)tok * 1024 + nt * 128 + chunk * 8;
      *(f32x4*)o = (f32x4){v[0], v[1], v[2], v[3]};
      *(f32x4*)(o + 4) = (f32x4){v[4], v[5], v[6], v[7]};
      *(u32x4*)(P.xbB + (size_t)tok * 1024 + nt * 128 + chunk * 8) = pk8(v[0], v[1], v[2], v[3], v[4], v[5], v[6], v[7]);
      if (chunk == 0) P.ssq1[tok * 8 + nt] = ss;
    } else if (SEG == 9) {
      *(u32x4*)(P.pe + (size_t)tok * 1024 + nt * 128 + chunk * 8) = pk8(v[0], v[1], v[2], v[3], v[4], v[5], v[6], v[7]);
    } else {
      const float rs = rsl[row];
      float* o = P.out + (size_t)tok * 1024 + nt * 128 + chunk * 8;
      const f32x4 x0 = pre.x0[pass], x1 = pre.x1[pass];
      const u32x4 pv = pre.pv[pass];
      float xo[8] = {x0.x, x0.y, x0.z, x0.w, x1.x, x1.y, x1.z, x1.w};
      const float pe[8] = {bflo(pv.x), bfhi(pv.x), bflo(pv.y), bfhi(pv.y), bflo(pv.z), bfhi(pv.z), bflo(pv.w), bfhi(pv.w)};
      float ss = 0.f;
#pragma unroll
      for (int j = 0; j < 8; ++j) { xo[j] += sigmoidf_(v[j] * rs) * pe[j]; ss += xo[j] * xo[j]; }
      ss = sum16(ss);
      *(f32x4*)o = (f32x4){xo[0], xo[1], xo[2], xo[3]};
      *(f32x4*)(o + 4) = (f32x4){xo[4], xo[5], xo[6], xo[7]};
      *(u32x4*)(P.xbA + (size_t)tok * 1024 + nt * 128 + chunk * 8) = pk8(xo[0], xo[1], xo[2], xo[3], xo[4], xo[5], xo[6], xo[7]);
      if (chunk == 0) P.ssqX[tok * 8 + nt] = ss;
    }
  }
}

template <int MODE>
__device__ __forceinline__ void epilogue(const Params& P, const int layer, const int mt, const int nt, LAS const float* C, LAS const float* rsl, const EpiPre& pre) {
  if (MODE == 1) {
    if (nt < 5) epi_loop<1>(P, layer, mt, nt, C, rsl, pre);
    else if (nt == 5) epi_loop<2>(P, layer, mt, nt, C, rsl, pre);
    else if (nt < 10 || (nt >= 15 && nt < 19)) epi_loop<3>(P, layer, mt, nt, C, rsl, pre);
    else if (nt < 15) epi_loop<4>(P, layer, mt, nt, C, rsl, pre);
    else epi_loop<5>(P, layer, mt, nt, C, rsl, pre);
  } else if (MODE == 2) epi_loop<6>(P, layer, mt, nt, C, rsl, pre);
  else if (MODE == 3) epi_loop<7>(P, layer, mt, nt, C, rsl, pre);
  else if (MODE == 4) epi_loop<8>(P, layer, mt, nt, C, rsl, pre);
  else if (MODE == 5) epi_loop<9>(P, layer, mt, nt, C, rsl, pre);
  else epi_loop<10>(P, layer, mt, nt, C, rsl, pre);
}

template <int MODE>
__device__ __forceinline__ void gemm2_tile(const Params& P, const int layer, const bf16_t* A, const bf16_t* Bt, const int K, const int mt, const int nt2, LAS char* lds) {
  float rs_mine = 0.f;
  const int t = tid_opaque();
  if (MODE != 4 && MODE != 5 && t < 128) {
    const int tok = mt * 128 + t;
    if (MODE == 1 || MODE == 6) {
      const float* sp = (MODE == 1 ? P.ssqX : P.ssq1) + tok * 8;
      const f32x4 a = *(const f32x4*)sp, bb = *(const f32x4*)(sp + 4);
      rs_mine = rsqrtf((((a.x + a.y) + (a.z + a.w)) + ((bb.x + bb.y) + (bb.z + bb.w))) * (1.f / 1024.f) + 1e-6f);
    } else if (MODE == 2) {
      const f32x4 a = *(const f32x4*)(P.ssqcq + tok * 4);
      rs_mine = rsqrtf((a.x + a.y + a.z) * (1.f / 384.f) + 1e-6f);
    } else {
      const f32x2 a = *(const f32x2*)(P.ssqckv + tok * 2);
      rs_mine = rsqrtf((a.x + a.y) * (1.f / 256.f) + 1e-6f);
    }
  }
  LAS float* rsl = (LAS float*)(lds + 67584);
  if (MODE != 4 && MODE != 5 && t < 128) rsl[t] = rs_mine;
  f32x4acc acc[4][8];
  gemm2_main<(MODE == 1 || MODE == 4 || MODE == 6)>(A, Bt, K, mt * 128, nt2 * 256, lds, acc);
#pragma unroll
  for (int hf = 0; hf < 2; ++hf) {
    EpiPre pre;
    if (MODE == 4) epi_prefetch<8>(P, layer, mt, nt2 * 2 + hf, pre);
    if (MODE == 6) epi_prefetch<10>(P, layer, mt, nt2 * 2 + hf, pre);
    dump_half((LAS float*)lds, acc, hf);
    __syncthreads();
    epilogue<MODE>(P, layer, mt, nt2 * 2 + hf, (LAS const float*)lds, rsl, pre);
    __syncthreads();
  }
}


template <int DQK, bool WIN>
__device__ __forceinline__ void attn_item(const Params& P, const int layer, const int b, const int head, const int qblk, LAS char* lds) {
  constexpr int KS = DQK / 16;
  constexpr int PK = DQK * 2 + 16;
  constexpr int PV = 192;
  constexpr int KTILE = 64 * PK, VTILE = 64 * PV;
  constexpr int KCH = DQK / 8;
  constexpr int NKL = 64 * KCH / 256;
  const int t = tid_opaque(), w = t >> 6, lane = t & 63, r = lane & 31, h = lane >> 5;
  const int q0 = qblk * 128;
  const bf16_t *Qp, *Kp, *Vp;
  if (WIN) {
    const int kvh = head >> 2;
    Qp = P.Qa + (size_t)(b * 8 + head) * SEQ * 64; Kp = P.Ka + (size_t)(b * 2 + kvh) * SEQ * 64; Vp = P.Va + (size_t)(b * 2 + kvh) * SEQ * 64;
  } else {
    Qp = P.Qb + (size_t)(b * 8 + head) * SEQ * 96; Kp = P.Kb + (size_t)(b * 8 + head) * SEQ * 96; Vp = P.Vb + (size_t)(b * 8 + head) * SEQ * 64;
  }
  const int klo = WIN ? (q0 >= 128 ? q0 - 128 : 0) : 0;
  const int khi = WIN ? (q0 + 256 <= SEQ ? q0 + 256 : SEQ) : SEQ;
  const int ntl = (khi - klo) >> 6;
  bf16x8 qf[KS];
  {
    const bf16_t* qrow = Qp + (size_t)(q0 + w * 32 + r) * DQK + h * 8;
#pragma unroll
    for (int ks = 0; ks < KS; ++ks) qf[ks] = *(const bf16x8*)(qrow + ks * 16);
  }
  f32x16 O[2];
#pragma unroll
  for (int e = 0; e < 16; ++e) { O[0][e] = 0.f; O[1][e] = 0.f; }
  float m, l;
  if (WIN) { m = P.a_sink[layer * 8 + head] * LOG2E; l = (h == 0) ? 1.f : 0.f; } else { m = -1e30f; l = 0.f; }
  const int qpos = q0 + w * 32 + r;

  u32x4 rk[NKL], rv[2];
  const char* Kg = (const char*)(Kp + (size_t)klo * DQK);
  const char* Vg = (const char*)(Vp + (size_t)klo * 64);
  int koff[NKL], voff[2];
#pragma unroll
  for (int i = 0; i < NKL; ++i) { const int c = t + 256 * i; koff[i] = (c / KCH) * PK + (c % KCH) * 16; }
#pragma unroll
  for (int i = 0; i < 2; ++i) { const int c = t + 256 * i; voff[i] = (c >> 3) * PV + (c & 7) * 16; }
  const int i16 = lane & 15, tq = i16 >> 2, tp = i16 & 3, blk = (lane >> 4) & 1;
  const int troff = (4 * h + tq) * PV + blk * 32 + tp * 8;

#pragma unroll
  for (int i = 0; i < NKL; ++i) rk[i] = *(const u32x4*)(Kg + (size_t)(t + 256 * i) * 16);
#pragma unroll
  for (int i = 0; i < 2; ++i) rv[i] = *(const u32x4*)(Vg + (size_t)(t + 256 * i) * 16);
#pragma unroll
  for (int i = 0; i < NKL; ++i) *(LAS u32x4*)(lds + koff[i]) = rk[i];
#pragma unroll
  for (int i = 0; i < 2; ++i) *(LAS u32x4*)(lds + KTILE + voff[i]) = rv[i];
  __syncthreads();

  for (int kt = 0; kt < ntl; ++kt) {
    const bool more = (kt + 1 < ntl);
    if (more) {
      const char* kg = Kg + (size_t)(kt + 1) * 64 * DQK * 2;
      const char* vg = Vg + (size_t)(kt + 1) * 64 * 64 * 2;
#pragma unroll
      for (int i = 0; i < NKL; ++i) rk[i] = *(const u32x4*)(kg + (size_t)(t + 256 * i) * 16);
#pragma unroll
      for (int i = 0; i < 2; ++i) rv[i] = *(const u32x4*)(vg + (size_t)(t + 256 * i) * 16);
    }
    LAS const char* sK = lds + (kt & 1) * (KTILE + VTILE);
    LAS const char* sV = sK + KTILE;
    f32x16 S[2];
#pragma unroll
    for (int sub = 0; sub < 2; ++sub) {
#pragma unroll
      for (int e = 0; e < 16; ++e) S[sub][e] = 0.f;
#pragma unroll
      for (int ks = 0; ks < KS; ++ks) {
        const bf16x8 kf = *(LAS const bf16x8*)(sK + (sub * 32 + r) * PK + ks * 32 + h * 16);
        S[sub] = MFMA32(kf, qf[ks], S[sub]);
      }
    }
    if (WIN) {
      const int kb = klo + kt * 64;
#pragma unroll
      for (int sub = 0; sub < 2; ++sub)
#pragma unroll
        for (int e = 0; e < 16; ++e) {
          const int d = kb + sub * 32 + crow(e, h) - qpos;
          if (d > 128 || d < -128) S[sub][e] = -1e30f;
        }
    }
    float mx = S[0][0];
#pragma unroll
    for (int e = 1; e < 16; ++e) mx = fmaxf(mx, S[0][e]);
#pragma unroll
    for (int e = 0; e < 16; ++e) mx = fmaxf(mx, S[1][e]);
    mx = fmaxf(mx, shflx(mx, 32, lane));
    const float mn = fmaxf(m, mx);
    const float alpha = __builtin_amdgcn_exp2f(m - mn);
    m = mn;
    float ls = 0.f;
#pragma unroll
    for (int sub = 0; sub < 2; ++sub)
#pragma unroll
      for (int e = 0; e < 16; ++e) { const float pv = __builtin_amdgcn_exp2f(S[sub][e] - mn); S[sub][e] = pv; ls += pv; }
    l = l * alpha + ls;
#pragma unroll
    for (int e = 0; e < 16; ++e) { O[0][e] *= alpha; O[1][e] *= alpha; }
#pragma unroll
    for (int sub = 0; sub < 2; ++sub)
#pragma unroll
      for (int s2 = 0; s2 < 2; ++s2) {
        u32x4 pw;
        pw.x = pk2(S[sub][8 * s2 + 0], S[sub][8 * s2 + 1]); pw.y = pk2(S[sub][8 * s2 + 2], S[sub][8 * s2 + 3]);
        pw.z = pk2(S[sub][8 * s2 + 4], S[sub][8 * s2 + 5]); pw.w = pk2(S[sub][8 * s2 + 6], S[sub][8 * s2 + 7]);
        const bf16x8 pf = __builtin_bit_cast(bf16x8, pw);
#pragma unroll
        for (int dvt = 0; dvt < 2; ++dvt) {
          LAS const char* va = sV + (sub * 32 + s2 * 16) * PV + dvt * 64 + troff;
          const s16x4 lo = __builtin_amdgcn_ds_read_tr16_b64_v4i16((LAS s16x4*)(va));
          const s16x4 hi = __builtin_amdgcn_ds_read_tr16_b64_v4i16((LAS s16x4*)(va + 8 * PV));
          const bf16x8 vf = __builtin_shufflevector(lo, hi, 0, 1, 2, 3, 4, 5, 6, 7);
          O[dvt] = MFMA32(vf, pf, O[dvt]);
        }
      }
    if (more) {
      LAS char* dK = lds + ((kt + 1) & 1) * (KTILE + VTILE);
#pragma unroll
      for (int i = 0; i < NKL; ++i) *(LAS u32x4*)(dK + koff[i]) = rk[i];
#pragma unroll
      for (int i = 0; i < 2; ++i) *(LAS u32x4*)(dK + KTILE + voff[i]) = rv[i];
    }
    __syncthreads();
  }
  l += shflx(l, 32, lane);
  const float inv = 1.0f / l;
  const int tok = b * SEQ + qpos;
  const int colb = (WIN ? 0 : 512) + head * 64;
  const bf16_t* gp = P.G + (size_t)tok * 1024 + colb;
  bf16_t* op = P.mix + (size_t)tok * 1024 + colb;
#pragma unroll
  for (int dvt = 0; dvt < 2; ++dvt)
#pragma unroll
    for (int g = 0; g < 4; ++g) {
      const int dv = dvt * 32 + 8 * g + 4 * h;
      const u32x2 gv = *(const u32x2*)(gp + dv);
      u32x2 ov;
      ov.x = pk2(O[dvt][4 * g + 0] * inv * bflo(gv.x), O[dvt][4 * g + 1] * inv * bfhi(gv.x));
      ov.y = pk2(O[dvt][4 * g + 2] * inv * bflo(gv.y), O[dvt][4 * g + 3] * inv * bfhi(gv.y));
      *(u32x2*)(op + dv) = ov;
    }
}

template <int DQK, bool WIN, bool FAST>
__device__ __forceinline__ void attn_item2(const Params& P, const int layer, const int b, const int head_in, const int qblk, LAS char* lds) {
  constexpr int KS = DQK / 16;
  constexpr int PK = DQK * 2 + 16;
  constexpr int PV = 192;
  constexpr int KTILE = 64 * PK, VTILE = 64 * PV;
  constexpr int KCH = DQK / 8;
  constexpr int NKL = 64 * KCH / 256;
  const int t = tid_opaque(), lane = t & 63, r = lane & 31, h = lane >> 5;
  const int w = __builtin_amdgcn_readfirstlane(t >> 6);
  const int q0 = WIN ? qblk * 64 : qblk * 256;
  const int head = WIN ? head_in * 4 + w : head_in;
  const bf16_t *Qp, *Kp, *Vp;
  if (WIN) {
    const int kvh = head_in;
    Qp = P.Qa + (size_t)(b * 8 + head) * SEQ * 64; Kp = P.Ka + (size_t)(b * 2 + kvh) * SEQ * 64; Vp = P.Va + (size_t)(b * 2 + kvh) * SEQ * 64;
  } else {
    Qp = P.Qb + (size_t)(b * 8 + head) * SEQ * 96; Kp = P.Kb + (size_t)(b * 8 + head) * SEQ * 96; Vp = P.Vb + (size_t)(b * 8 + head) * SEQ * 64;
  }
  const int klo = WIN ? (q0 >= 128 ? q0 - 128 : 0) : 0;
  const int khi = WIN ? (q0 + 192 <= SEQ ? q0 + 192 : SEQ) : SEQ;
  const int ntl = (khi - klo) >> 6;
  const int wq0 = WIN ? q0 : q0 + w * 64;
  bf16x8 qf[2][KS];
#pragma unroll
  for (int qt = 0; qt < 2; ++qt) {
    const bf16_t* qrow = Qp + (size_t)(wq0 + qt * 32 + r) * DQK + h * 8;
#pragma unroll
    for (int ks = 0; ks < KS; ++ks) qf[qt][ks] = *(const bf16x8*)(qrow + ks * 16);
  }
  f32x16 O[2][2];
#pragma unroll
  for (int e = 0; e < 16; ++e) { O[0][0][e] = 0.f; O[0][1][e] = 0.f; O[1][0][e] = 0.f; O[1][1][e] = 0.f; }
  float m[2], l[2];
  {
    const float sink2 = WIN ? P.a_sink[layer * 8 + head] * LOG2E : 0.f;
#pragma unroll
    for (int qt = 0; qt < 2; ++qt) {
      if (FAST) { m[qt] = 0.f; l[qt] = (WIN && h == 0) ? __builtin_amdgcn_exp2f(sink2) : 0.f; }
      else if (WIN) { m[qt] = sink2; l[qt] = (h == 0) ? 1.f : 0.f; }
      else { m[qt] = -1e30f; l[qt] = 0.f; }
    }
  }
  u32x4 rk[NKL], rv[2];
  const char* Kg = (const char*)(Kp + (size_t)klo * DQK);
  const char* Vg = (const char*)(Vp + (size_t)klo * 64);
  int koff[NKL], voff[2];
#pragma unroll
  for (int i = 0; i < NKL; ++i) { const int c = t + 256 * i; koff[i] = (c / KCH) * PK + (c % KCH) * 16; }
#pragma unroll
  for (int i = 0; i < 2; ++i) { const int c = t + 256 * i; voff[i] = (c >> 3) * PV + (c & 7) * 16; }
  const int i16 = lane & 15, tq = i16 >> 2, tp = i16 & 3, blk = (lane >> 4) & 1;
  const int troff = (4 * h + tq) * PV + blk * 32 + tp * 8;
#pragma unroll
  for (int i = 0; i < NKL; ++i) rk[i] = *(const u32x4*)(Kg + (unsigned)((t + 256 * i) * 16));
#pragma unroll
  for (int i = 0; i < 2; ++i) rv[i] = *(const u32x4*)(Vg + (unsigned)((t + 256 * i) * 16));
#pragma unroll
  for (int i = 0; i < NKL; ++i) *(LAS u32x4*)(lds + koff[i]) = rk[i];
#pragma unroll
  for (int i = 0; i < 2; ++i) *(LAS u32x4*)(lds + KTILE + voff[i]) = rv[i];
  __syncthreads();

  for (int kt = 0; kt < ntl; ++kt) {
    const bool more = (kt + 1 < ntl);
    if (more) {
      const char* kg = Kg + (size_t)(kt + 1) * 64 * DQK * 2;
      const char* vg = Vg + (size_t)(kt + 1) * 64 * 64 * 2;
#pragma unroll
      for (int i = 0; i < NKL; ++i) rk[i] = *(const u32x4*)(kg + (unsigned)((t + 256 * i) * 16));
#pragma unroll
      for (int i = 0; i < 2; ++i) rv[i] = *(const u32x4*)(vg + (unsigned)((t + 256 * i) * 16));
    }
    LAS const char* sK = lds + (kt & 1) * (KTILE + VTILE);
    LAS const char* sV = sK + KTILE;
    const int kb = klo + kt * 64;
    const bool active = !WIN || ((kb + 63 >= wq0 - 128) && (kb <= wq0 + 63 + 128));
    if (active) {
#pragma unroll
      for (int sub = 0; sub < 2; ++sub) {
        f32x16 S[2];
#pragma unroll
        for (int qt = 0; qt < 2; ++qt) {
#pragma unroll
          for (int e = 0; e < 16; ++e) S[qt][e] = 0.f;
#pragma unroll
          for (int ks = 0; ks < KS; ++ks) {
            const bf16x8 kf = *(LAS const bf16x8*)(sK + (sub * 32 + r) * PK + ks * 32 + h * 16);
            S[qt] = MFMA32(kf, qf[qt][ks], S[qt]);
          }
        }
#pragma unroll
        for (int qt = 0; qt < 2; ++qt) {
          if (WIN) {
            const int dq = kb + sub * 32 - (wq0 + qt * 32 + r);
#pragma unroll
            for (int e = 0; e < 16; ++e) { const int d = dq + crow(e, h); if (d > 128 || d < -128) S[qt][e] = -1e30f; }
          }
          float ls = 0.f;
          if (FAST) {
#pragma unroll
            for (int e = 0; e < 16; ++e) { const float pv = __builtin_amdgcn_exp2f(S[qt][e]); S[qt][e] = pv; ls += pv; }
            l[qt] += ls;
          } else {
            float mx = S[qt][0];
#pragma unroll
            for (int e = 1; e < 16; ++e) mx = fmaxf(mx, S[qt][e]);
            mx = fmaxf(mx, shflx(mx, 32, lane));
            const float mn = fmaxf(m[qt], mx);
            const float alpha = __builtin_amdgcn_exp2f(m[qt] - mn);
            m[qt] = mn;
#pragma unroll
            for (int e = 0; e < 16; ++e) { const float pv = __builtin_amdgcn_exp2f(S[qt][e] - mn); S[qt][e] = pv; ls += pv; }
            l[qt] = l[qt] * alpha + ls;
#pragma unroll
            for (int e = 0; e < 16; ++e) { O[qt][0][e] *= alpha; O[qt][1][e] *= alpha; }
          }
#pragma unroll
          for (int s2 = 0; s2 < 2; ++s2) {
            u32x4 pw;
            pw.x = pk2(S[qt][8 * s2 + 0], S[qt][8 * s2 + 1]); pw.y = pk2(S[qt][8 * s2 + 2], S[qt][8 * s2 + 3]);
            pw.z = pk2(S[qt][8 * s2 + 4], S[qt][8 * s2 + 5]); pw.w = pk2(S[qt][8 * s2 + 6], S[qt][8 * s2 + 7]);
            const bf16x8 pf = __builtin_bit_cast(bf16x8, pw);
            if (!WIN && sub == 1 && qt == 1 && s2 == 1) {
              bf16x8 vfa[2];
#pragma unroll
              for (int dvt = 0; dvt < 2; ++dvt) {
                LAS const char* va = sV + (sub * 32 + s2 * 16) * PV + dvt * 64 + troff;
                const s16x4 lo = __builtin_amdgcn_ds_read_tr16_b64_v4i16((LAS s16x4*)(va));
                const s16x4 hi = __builtin_amdgcn_ds_read_tr16_b64_v4i16((LAS s16x4*)(va + 8 * PV));
                vfa[dvt] = __builtin_shufflevector(lo, hi, 0, 1, 2, 3, 4, 5, 6, 7);
              }
              if (more) {
                LAS char* dK = lds + ((kt + 1) & 1) * (KTILE + VTILE);
#pragma unroll
                for (int i = 0; i < NKL; ++i) *(LAS u32x4*)(dK + koff[i]) = rk[i];
#pragma unroll
                for (int i = 0; i < 2; ++i) *(LAS u32x4*)(dK + KTILE + voff[i]) = rv[i];
              }
              __syncthreads();
              O[qt][0] = MFMA32(vfa[0], pf, O[qt][0]);
              O[qt][1] = MFMA32(vfa[1], pf, O[qt][1]);
            } else {
#pragma unroll
              for (int dvt = 0; dvt < 2; ++dvt) {
                LAS const char* va = sV + (sub * 32 + s2 * 16) * PV + dvt * 64 + troff;
                const s16x4 lo = __builtin_amdgcn_ds_read_tr16_b64_v4i16((LAS s16x4*)(va));
                const s16x4 hi = __builtin_amdgcn_ds_read_tr16_b64_v4i16((LAS s16x4*)(va + 8 * PV));
                const bf16x8 vf = __builtin_shufflevector(lo, hi, 0, 1, 2, 3, 4, 5, 6, 7);
                O[qt][dvt] = MFMA32(vf, pf, O[qt][dvt]);
              }
            }
          }
        }
      }
    }
    if (WIN) {
      if (more) {
        LAS char* dK = lds + ((kt + 1) & 1) * (KTILE + VTILE);
#pragma unroll
        for (int i = 0; i < NKL; ++i) *(LAS u32x4*)(dK + koff[i]) = rk[i];
#pragma unroll
        for (int i = 0; i < 2; ++i) *(LAS u32x4*)(dK + KTILE + voff[i]) = rv[i];
      }
      __syncthreads();
    }
  }
#pragma unroll
  for (int qt = 0; qt < 2; ++qt) {
    float lt = l[qt];
    lt += shflx(lt, 32, lane);
    const float inv = 1.0f / lt;
    const int tok = b * SEQ + wq0 + qt * 32 + r;
    const int colb = (WIN ? 0 : 512) + head * 64;
    const bf16_t* gp = P.G + (size_t)tok * 1024 + colb;
    bf16_t* op = P.mix + (size_t)tok * 1024 + colb;
#pragma unroll
    for (int dvt = 0; dvt < 2; ++dvt)
#pragma unroll
      for (int g = 0; g < 4; g += 2) {
        u32x2 pk[2];
#pragma unroll
        for (int q = 0; q < 2; ++q) {
          const int dv = dvt * 32 + 8 * (g + q) + 4 * h;
          const u32x2 gv = *(const u32x2*)(gp + dv);
          pk[q].x = pk2(O[qt][dvt][4 * (g + q) + 0] * inv * bflo(gv.x), O[qt][dvt][4 * (g + q) + 1] * inv * bfhi(gv.x));
          pk[q].y = pk2(O[qt][dvt][4 * (g + q) + 2] * inv * bflo(gv.y), O[qt][dvt][4 * (g + q) + 3] * inv * bfhi(gv.y));
        }
        const auto rx = __builtin_amdgcn_permlane32_swap(pk[0].x, pk[1].x, false, false);
        const auto ry = __builtin_amdgcn_permlane32_swap(pk[0].y, pk[1].y, false, false);
        u32x4 ov; ov.x = rx[0]; ov.y = ry[0]; ov.z = rx[1]; ov.w = ry[1];
        *(u32x4*)(op + dvt * 32 + 8 * g + 8 * h) = ov;
      }
  }
}

__device__ __forceinline__ void conv_w(bf16_t* __restrict__ dst, const float* __restrict__ src, const float* __restrict__ g, const int K, const int Nsrc, const int Ndst, const int mode,
                                       const int gtid, const int gsz) {
  const int items = Ndst * (K >> 3);
  for (int it = gtid; it < items; it += gsz) {
    const int n = it % Ndst, kc = it / Ndst;
    int col;
    if (mode == 0) col = n;
    else if (mode == 1) col = n < 1920 ? n : (n < 2432 ? n + 32 : (n < 2464 ? n - 512 : -1));
    else { const int hh = n >> 7, c = n & 127; col = c < 96 ? hh * 96 + c : -1; }
    float v[8];
#pragma unroll
    for (int j = 0; j < 8; ++j) {
      const int k = kc * 8 + j;
      float val = 0.f;
      if (col >= 0) { val = src[(size_t)k * Nsrc + col]; if (g) val *= g[k]; }
      v[j] = val;
    }
    *(u32x4*)(dst + (size_t)n * K + kc * 8) = pk8(v[0], v[1], v[2], v[3], v[4], v[5], v[6], v[7]);
  }
}

__device__ __forceinline__ void phase0(const Params& P) {
  const int gtid = blockIdx.x * 256 + tid_opaque(), gsz = gridDim.x * 256;
  for (int l = 0; l < 4; ++l) {
    conv_w(P.WinT + (size_t)l * 2560 * 1024, P.w_in + (size_t)l * 1024 * 2464, P.norm_g + l * 1024, 1024, 2464, 2560, 1, gtid, gsz);
    conv_w(P.WuqT + (size_t)l * 1024 * 384, P.b_w_uq + (size_t)l * 384 * 768, P.b_cq_norm + l * 384, 384, 768, 1024, 2, gtid, gsz);
    conv_w(P.WukvT + (size_t)l * 1024 * 256, P.b_w_ukv + (size_t)l * 256 * 1024, P.b_ckv_norm + l * 256, 256, 1024, 1024, 0, gtid, gsz);
    conv_w(P.WoutT + (size_t)l * 1024 * 1024, P.w_out + (size_t)l * 1024 * 1024, nullptr, 1024, 1024, 1024, 0, gtid, gsz);
    conv_w(P.WgT + (size_t)l * 1024 * 1024, P.ple_w_gate + (size_t)l * 1024 * 1024, P.ple_g + l * 1024, 1024, 1024, 1024, 0, gtid, gsz);
    conv_w(P.WpT + (size_t)l * 1024 * 256, P.ple_w_proj + (size_t)l * 256 * 1024, nullptr, 256, 1024, 1024, 0, gtid, gsz);
  }
  {
    const int gw = gtid >> 6, nw = gsz >> 6, lane = threadIdx.x & 63;
    for (int row0 = gw; row0 < T_TOK; row0 += 4 * nw) {
      f32x4 a[4][4];
#pragma unroll
      for (int q = 0; q < 4; ++q) {
        const int row = row0 + q * nw;
        const float* xr = P.x + (size_t)(row < T_TOK ? row : row0) * 1024;
#pragma unroll
        for (int i = 0; i < 4; ++i) a[q][i] = *(const f32x4*)(xr + i * 256 + lane * 4);
      }
#pragma unroll
      for (int q = 0; q < 4; ++q) {
        const int row = row0 + q * nw;
        if (row < T_TOK) {
          float ss = 0.f;
#pragma unroll
          for (int i = 0; i < 4; ++i) {
            ss += a[q][i].x * a[q][i].x + a[q][i].y * a[q][i].y + a[q][i].z * a[q][i].z + a[q][i].w * a[q][i].w;
            u32x2 o; o.x = pk2(a[q][i].x, a[q][i].y); o.y = pk2(a[q][i].z, a[q][i].w);
            *(u32x2*)(P.xbA + (size_t)row * 1024 + i * 256 + lane * 4) = o;
          }
          ss += shflx(ss, 32, lane); ss += shflx(ss, 16, lane); ss += shflx(ss, 8, lane); ss += shflx(ss, 4, lane); ss += shflx(ss, 2, lane); ss += shflx(ss, 1, lane);
          if (lane < 8) P.ssqX[row * 8 + lane] = (lane == 0) ? ss : 0.f;
        }
      }
    }
  }
  if (blockIdx.x == 0 && threadIdx.x < 4) {
    const int l = threadIdx.x;
    float gq = 0.f, gk = 0.f, aq = 0.f, ak = 0.f, sk = 0.f;
    for (int i = 0; i < 96; ++i) { gq = fmaxf(gq, fabsf(P.b_q_norm[l * 96 + i])); gk = fmaxf(gk, fabsf(P.b_k_norm[l * 96 + i])); }
    for (int i = 0; i < 64; ++i) { aq = fmaxf(aq, fabsf(P.a_q_norm[l * 64 + i])); ak = fmaxf(ak, fabsf(P.a_k_norm[l * 64 + i])); }
    for (int i = 0; i < 8; ++i) sk = fmaxf(sk, fabsf(P.a_sink[l * 8 + i]));
    const float bb = QB_SCALE * 96.f * gq * gk, ba = QA_SCALE * 64.f * aq * ak;
    P.flags[l] = (bb <= 60.f) ? 1 : 0;
    P.flags[4 + l] = (ba <= 60.f && sk * LOG2E <= 60.f) ? 1 : 0;
  }
  for (int idx = gtid; idx < T_TOK * 32; idx += gsz) {
    const int tok = idx >> 5, i = idx & 31;
    const float ang = (float)P.pos[tok] * P.invA[i];
    const double rev = (double)ang * 0.15915494309189535; const float fr = (float)(rev - rint(rev));
    P.cosA[idx] = __builtin_amdgcn_cosf(fr); P.sinA[idx] = __builtin_amdgcn_sinf(fr);
  }
  for (int idx = gtid; idx < T_TOK * 16; idx += gsz) {
    const int tok = idx >> 4, i = idx & 15;
    const float ang = (float)P.pos[tok] * P.invB[i];
    const double rev = (double)ang * 0.15915494309189535; const float fr = (float)(rev - rint(rev));
    P.cosB[idx] = __builtin_amdgcn_cosf(fr); P.sinB[idx] = __builtin_amdgcn_sinf(fr);
  }
}


#define XB_TMO      128
#define XB_XCNT(j)  (256  + 64 * (j))
#define XB_XSUB(j)  (1280 + 64 * (j))
#define XB_XGEN(j)  (2304 + 64 * (j))
#define XB_TOP      3328
#define XB_TOPGEN   3392
#define XCD_BAR_WORDS 3456
#define XB_SPIN_CAP (1u << 20)
__device__ __forceinline__ unsigned xb_ld(unsigned* p)              { return __hip_atomic_load(p, __ATOMIC_RELAXED, __HIP_MEMORY_SCOPE_AGENT); }
__device__ __forceinline__ unsigned xb_add(unsigned* p, unsigned v) { return __hip_atomic_fetch_add(p, v, __ATOMIC_RELAXED, __HIP_MEMORY_SCOPE_AGENT); }
__device__ __forceinline__ unsigned xb_xcc_id() { return (unsigned)__builtin_amdgcn_s_getreg((3 << 11) | 20) & 0xFu; }
#define XB_SPIN(cond, bar) do { unsigned _sp = 0; while (cond) { __builtin_amdgcn_s_sleep(1); \
    if ((++_sp & 255u) == 0u) { if (xb_ld(&(bar)[XB_TMO])) break; if (_sp > XB_SPIN_CAP) { atomicAdd(&(bar)[XB_TMO], 1u); break; } } } } while (0)
struct XcdBarrier { unsigned* bar; unsigned x; volatile LAS unsigned* st; };
__device__ __forceinline__ XcdBarrier xcd_barrier_post(unsigned* bar, volatile LAS unsigned* st) {
  XcdBarrier b; b.bar = bar; b.x = xb_xcc_id(); b.st = st;
  if (threadIdx.x == 0) (void)xb_add(&bar[XB_XCNT(b.x)], 1u);
  return b;
}
__device__ __forceinline__ void xcd_barrier_complete(unsigned* bar, unsigned x, unsigned& nloc, unsigned& nx) {
  const unsigned G = gridDim.x * gridDim.y * gridDim.z;
  unsigned sum, cnt, mine, sp = 0u;
  for (;;) {
    sum = 0u; cnt = 0u; mine = 0u;
#pragma unroll
    for (unsigned j = 0; j < 16; ++j) { const unsigned c = xb_ld(&bar[XB_XCNT(j)]); sum += c; cnt += (c > 0u) ? 1u : 0u; mine = (j == x) ? c : mine; }
    if (sum == G) break;
    __builtin_amdgcn_s_sleep(1);
    if ((++sp & 255u) == 0u) { if (xb_ld(&bar[XB_TMO])) break; if (sp > XB_SPIN_CAP) { atomicAdd(&bar[XB_TMO], 1u); break; } }
  }
  nloc = mine > 0u ? mine : 1u; nx = cnt > 0u ? cnt : 1u;
}
__device__ __forceinline__ void xcd_barrier(const XcdBarrier& b) {
  asm volatile("s_waitcnt vmcnt(0)" ::: "memory");
  __syncthreads();
  if (threadIdx.x == 0) {
    unsigned* bar = b.bar;
    unsigned bx = __builtin_amdgcn_readfirstlane(b.x);
    asm volatile("" : "+s"(bx));
    __builtin_amdgcn_s_waitcnt(0);
    unsigned nloc = b.st[0], nx = b.st[1];
    if (nloc == 0u) { xcd_barrier_complete(bar, bx, nloc, nx); b.st[0] = nloc; b.st[1] = nx; }
    const unsigned old = xb_add(&bar[XB_XSUB(bx)], 1u);
    const unsigned gen = old / nloc;
    if (old + 1u == (gen + 1u) * nloc) {
      __builtin_amdgcn_fence(__ATOMIC_RELEASE, "agent");
      asm volatile("s_waitcnt vmcnt(0)" ::: "memory");
      const unsigned og = xb_add(&bar[XB_TOP], 1u);
      const unsigned tg = og / nx;
      if (og + 1u == (tg + 1u) * nx) xb_add(&bar[XB_TOPGEN], 1u);
      else XB_SPIN(xb_ld(&bar[XB_TOPGEN]) == tg, bar);
      __builtin_amdgcn_fence(__ATOMIC_ACQUIRE, "agent");
      xb_add(&bar[XB_XGEN(bx)], 1u);
      asm volatile("s_waitcnt vmcnt(0)" ::: "memory");
    } else {
      XB_SPIN(xb_ld(&bar[XB_XGEN(bx)]) == gen, bar);
      __builtin_amdgcn_fence(__ATOMIC_ACQUIRE, "agent");
      asm volatile("s_waitcnt vmcnt(0)" ::: "memory");
    }
  }
  __syncthreads();
}

typedef const __attribute__((address_space(4))) Params* KargPtr;
#define KARGS(name) KargPtr name##_p = (KargPtr)__builtin_amdgcn_kernarg_segment_ptr(); asm volatile("" : "+s"(name##_p)); const Params& name = *(const Params*)name##_p
__global__ void __launch_bounds__(256, 2) hybrid_fwd(const Params PK) {
  __shared__ __attribute__((aligned(16))) char smem[73728];
  LAS char* lds = (LAS char*)smem;
  __shared__ uint4 xb_words;
  cg::grid_group grid = cg::this_grid();
  if (threadIdx.x == 0) xb_words = make_uint4(0u, 0u, 0u, 0u);
  __syncthreads();
  const XcdBarrier xb = xcd_barrier_post(PK.bar, (volatile LAS unsigned*)&xb_words);
  { KARGS(P); phase0(P); }
  if (PK.bar == nullptr) grid.sync();
  xcd_barrier(xb);
  for (int layer = 0; layer < 4; ++layer) {
    int tile, tm, tn;
    {
    KARGS(P);
    for (int it = 0; next_tile2(it, 10, tm, tn); ++it)
      gemm2_tile<1>(P, layer, P.xbA, P.WinT + (size_t)layer * 2560 * 1024, 1024, tm, tn, lds);
    }
    xcd_barrier(xb);
    {
    KARGS(P);
    for (int it = 0; next_tile2(it, 4, tm, tn); ++it)
      gemm2_tile<2>(P, layer, P.cq, P.WuqT + (size_t)layer * 1024 * 384, 384, tm, tn, lds);
    for (int it = 0; next_tile2(it, 4, tm, tn); ++it)
      gemm2_tile<3>(P, layer, P.ckv, P.WukvT + (size_t)layer * 1024 * 256, 256, tm, tn, lds);
    }
    xcd_barrier(xb);
    {
    KARGS(P);
    {
      const float* ps = P.p + (size_t)layer * T_TOK * 256;
      int zb; asm volatile("s_mov_b32 %0, 0" : "=s"(zb));
      const int gtid = ((int)blockIdx.x + zb) * 256 + (int)threadIdx.x, gsz = gridDim.x * 256;
      for (int c0 = gtid; c0 < T_TOK * 32; c0 += 4 * gsz) {
        f32x4 a[4][2];
#pragma unroll
        for (int q = 0; q < 4; ++q) { const int c = c0 + q * gsz; const float* src = ps + (size_t)(c < T_TOK * 32 ? c : c0) * 8; a[q][0] = *(const f32x4*)src; a[q][1] = *(const f32x4*)(src + 4); }
#pragma unroll
        for (int q = 0; q < 4; ++q) { const int c = c0 + q * gsz; if (c < T_TOK * 32) *(u32x4*)(P.pb + (size_t)c * 8) = pk8(a[q][0].x, a[q][0].y, a[q][0].z, a[q][0].w, a[q][1].x, a[q][1].y, a[q][1].z, a[q][1].w); }
      }
    }
    if (P.flags[layer]) { for (int it = 0; next_tile(it, 1024, tile); ++it) attn_item2<96, false, true>(P, layer, tile >> 7, (tile >> 4) & 7, tile & 15, lds); }
    else { for (int it = 0; next_tile(it, 2048, tile); ++it) attn_item<96, false>(P, layer, tile >> 8, (tile >> 5) & 7, tile & 31, lds); }
    if (P.flags[4 + layer]) { for (int it = 0; next_tile(it, 1024, tile); ++it) attn_item2<64, true, true>(P, layer, tile >> 7, (tile >> 6) & 1, tile & 63, lds); }
    else { for (int it = 0; next_tile(it, 2048, tile); ++it) attn_item<64, true>(P, layer, tile >> 8, (tile >> 5) & 7, tile & 31, lds); }
    }
    xcd_barrier(xb);
    {
    KARGS(P);
    for (int it = 0; next_tile2(it, 4, tm, tn); ++it)
      gemm2_tile<4>(P, layer, P.mix, P.WoutT + (size_t)layer * 1024 * 1024, 1024, tm, tn, lds);
    for (int it = 0; next_tile2(it, 4, tm, tn); ++it)
      gemm2_tile<5>(P, layer, P.pb, P.WpT + (size_t)layer * 1024 * 256, 256, tm, tn, lds);
    }
    xcd_barrier(xb);
    {
    KARGS(P);
    for (int it = 0; next_tile2(it, 4, tm, tn); ++it)
      gemm2_tile<6>(P, layer, P.xbB, P.WgT + (size_t)layer * 1024 * 1024, 1024, tm, tn, lds);
    }
    xcd_barrier(xb);
  }
}

extern "C" void kernel_launch(void* const* d_in, const int* in_sizes, int n_in, void* d_out, int out_size, void* d_ws, size_t ws_size, hipStream_t stream) {
  static Params P;
  memset(&P, 0, sizeof(P));
  P.x = (const float*)d_in[0]; P.p = (const float*)d_in[1]; P.pos = (const int*)d_in[2];
  P.norm_g = (const float*)d_in[3]; P.w_in = (const float*)d_in[4]; P.a_q_norm = (const float*)d_in[5]; P.a_k_norm = (const float*)d_in[6]; P.a_sink = (const float*)d_in[7];
  P.b_cq_norm = (const float*)d_in[8]; P.b_ckv_norm = (const float*)d_in[9]; P.b_w_uq = (const float*)d_in[10]; P.b_w_ukv = (const float*)d_in[11];
  P.b_q_norm = (const float*)d_in[12]; P.b_k_norm = (const float*)d_in[13]; P.w_out = (const float*)d_in[14]; P.ple_g = (const float*)d_in[15];
  P.ple_w_gate = (const float*)d_in[16]; P.ple_w_proj = (const float*)d_in[17];
  P.out = (float*)d_out;
  char* ws = (char*)d_ws; size_t off = 0;
  auto take = [&](size_t bytes) { char* p = ws + off; off += (bytes + 255) & ~(size_t)255; return p; };
  const size_t T = T_TOK;
  P.WinT = (bf16_t*)take((size_t)4 * 2560 * 1024 * 2);
  P.WuqT = (bf16_t*)take((size_t)4 * 1024 * 384 * 2);
  P.WukvT = (bf16_t*)take((size_t)4 * 1024 * 256 * 2);
  P.WoutT = (bf16_t*)take((size_t)4 * 1024 * 1024 * 2);
  P.WgT = (bf16_t*)take((size_t)4 * 1024 * 1024 * 2);
  P.WpT = (bf16_t*)take((size_t)4 * 1024 * 256 * 2);
  P.cosA = (float*)take(T * 32 * 4); P.sinA = (float*)take(T * 32 * 4);
  P.cosB = (float*)take(T * 16 * 4); P.sinB = (float*)take(T * 16 * 4);
  P.xbA = (bf16_t*)take(T * 1024 * 2); P.xbB = (bf16_t*)take(T * 1024 * 2);
  P.Qa = (bf16_t*)take(T * 512 * 2); P.Ka = (bf16_t*)take(T * 128 * 2); P.Va = (bf16_t*)take(T * 128 * 2);
  P.G = (bf16_t*)take(T * 1024 * 2);
  {
    char* mixr = take(T * 1024 * 2);
    P.mix = (bf16_t*)mixr; P.cq = (bf16_t*)mixr; P.ckv = (bf16_t*)(mixr + T * 384 * 2); P.bkr = (float*)(mixr + T * 384 * 2 + T * 256 * 2);
  }
  {
    char* qk = take(T * 768 * 2 * 2);
    P.Qb = (bf16_t*)qk; P.Kb = (bf16_t*)(qk + T * 768 * 2); P.pe = (bf16_t*)qk;
  }
  P.Vb = (bf16_t*)take(T * 512 * 2);
  P.pb = (bf16_t*)take(T * 256 * 2);
  P.bar = (unsigned*)take(XCD_BAR_WORDS * 4);
  P.flags = (int*)take(256);
  P.ssqX = (float*)take(T * 8 * 4); P.ssq1 = (float*)take(T * 8 * 4); P.ssqcq = (float*)take(T * 4 * 4); P.ssqckv = (float*)take(T * 2 * 4);
  for (int i = 0; i < 32; ++i) P.invA[i] = (float)pow(10000.0, -(double)i * 2.0 / 64.0);
  for (int i = 0; i < 16; ++i) P.invB[i] = (float)pow(10000.0, -(double)i * 2.0 / 32.0);
  if (off > ws_size) fprintf(stderr, "workspace too small: need %zu have %zu\n", off, ws_size);

  static int grid_blocks = 0;
  if (!grid_blocks) {
    int dev = 0, cus = 0, per_cu = 0;
    (void)hipGetDevice(&dev);
    (void)hipDeviceGetAttribute(&cus, hipDeviceAttributeMultiprocessorCount, dev);
    (void)hipOccupancyMaxActiveBlocksPerMultiprocessor(&per_cu, hybrid_fwd, 256, 0);
    if (per_cu > 2) per_cu = 2;
    if (per_cu < 1) per_cu = 1;
    grid_blocks = cus * per_cu;
    grid_blocks &= ~7;
  }
  (void)hipMemsetAsync(P.bar, 0, XCD_BAR_WORDS * 4, stream);
  void* args[] = {(void*)&P};
  hipError_t e = hipLaunchCooperativeKernel((const void*)hybrid_fwd, dim3(grid_blocks), dim3(256), args, 0, stream);
  if (e != hipSuccess) fprintf(stderr, "cooperative launch failed: %s (grid %d)\n", hipGetErrorString(e), grid_blocks);
}
```
